# Optimizing an MI355X kernel written in HIP

```python
import math
import jax, jax.numpy as jnp
from jax import lax
import numpy as np

D_MODEL = 1024
BATCH = 4
SEQ = 4096
DEPTH = 1

MIX_WIDTH = D_MODEL
GLA_WIDTH = MIX_WIDTH // 2
GLA_HEADS = 4
GLA_DV = GLA_WIDTH // GLA_HEADS
GLA_DK = GLA_DV // 2
GLA_KEY_WIDTH = GLA_HEADS * GLA_DK
GLA_GATE_RANK = 16
GLA_GATE_TEMP = 16.0
GLA_CHUNK = 16
DIL_WIDTH = MIX_WIDTH - GLA_WIDTH
DIL_HEADS = 8
DIL_DH = DIL_WIDTH // DIL_HEADS
DIL_CONFIGS = ((128, 1), (512, 4), (2048, 16))
DIL_BLOCK = 128
N_GROUPS = 4
EXPERTS_PER_GROUP = 8
N_EXPERTS = N_GROUPS * EXPERTS_PER_GROUP
TOP_K_INNER = 2
D_FF_EXPERT = 512
MOE_BLOCK = 128
DEEPNORM_ALPHA = (2.0 * DEPTH) ** 0.25
DEEPNORM_BETA = (8.0 * DEPTH) ** -0.25
EPS = 1e-5
SPLIT_SIZES = (GLA_KEY_WIDTH, GLA_KEY_WIDTH, GLA_WIDTH, GLA_WIDTH, GLA_GATE_RANK, DIL_WIDTH, DIL_WIDTH, DIL_WIDTH)
SPLIT_IS_VALUE = (False, False, True, False, False, False, False, True)
SPLIT_POINTS = tuple(int(v) for v in np.cumsum(SPLIT_SIZES)[:-1])
PROJ_WIDTH = int(sum(SPLIT_SIZES))

kernel_name = "hymba_gla_dilated_alibi_hmoe_deepnorm"


def layer_norm(x, g, b):
    xf = x.astype(jnp.float32)
    mu = jnp.mean(xf, axis=-1, keepdims=True)
    var = jnp.mean(jnp.square(xf - mu), axis=-1, keepdims=True)
    return ((xf - mu) * lax.rsqrt(var + EPS)).astype(x.dtype) * g + b


def rms_norm(x, g):
    xf = x.astype(jnp.float32)
    return (xf * lax.rsqrt(jnp.mean(xf * xf, axis=-1, keepdims=True) + EPS)).astype(x.dtype) * g


def to_heads(t, n_heads):
    b, s, w = t.shape
    return t.reshape(b, s, n_heads, w // n_heads).transpose(0, 2, 1, 3)


def from_heads(t):
    b, h, s, d = t.shape
    return t.transpose(0, 2, 1, 3).reshape(b, s, h * d)


def gla_chunked(q, k, v, log_a):
    B, H, S, dk = q.shape
    dv = v.shape[-1]
    C = GLA_CHUNK
    n = S // C
    q = q.reshape(B, H, n, C, dk)
    k = k.reshape(B, H, n, C, dk)
    v = v.reshape(B, H, n, C, dv)
    b = jnp.cumsum(log_a.astype(jnp.float32).reshape(B, H, n, C, dk), axis=3)
    b_last = b[:, :, :, -1:, :]
    causal = jnp.tril(jnp.ones((C, C), dtype=bool))
    diff = b[:, :, :, :, None, :] - b[:, :, :, None, :, :]
    decay_ij = jnp.exp(jnp.where(causal[:, :, None], diff, -jnp.inf))
    A = jnp.sum(q[:, :, :, :, None, :] * k[:, :, :, None, :, :] * decay_ij, axis=-1)
    o_intra = jnp.einsum('bhnij,bhnje->bhnie', A, v)
    dS = jnp.einsum('bhncd,bhnce->bhnde', k * jnp.exp(b_last - b), v)
    chunk_decay = jnp.exp(b_last[:, :, :, 0, :])

    def step(state, inp):
        ds_n, dec_n = inp
        return state * dec_n[..., None] + ds_n, state

    s0 = jnp.zeros((B, H, dk, dv), dS.dtype)
    _, s_before = lax.scan(step, s0, (jnp.moveaxis(dS, 2, 0), jnp.moveaxis(chunk_decay, 2, 0)))
    s_before = jnp.moveaxis(s_before, 0, 2)
    o_inter = jnp.einsum('bhncd,bhnde->bhnce', q * jnp.exp(b), s_before)
    return (o_intra + o_inter).reshape(B, H, S, dv).astype(v.dtype)


def dilated_branch(q, k, v, slopes, window, dilation):
    B, H, S, dh = q.shape
    r = dilation
    L = S // r
    w = window // r
    nb = -(-L // DIL_BLOCK)
    Lp = nb * DIL_BLOCK

    def to_sub(t):
        t = t.reshape(B, H, L, r, dh).transpose(0, 1, 3, 2, 4)
        t = jnp.pad(t, ((0, 0), (0, 0), (0, 0), (0, Lp - L), (0, 0)))
        return t.reshape(B, H, r, nb, DIL_BLOCK, dh)

    qs, ks, vs = to_sub(q), to_sub(k), to_sub(v)

    def band(t):
        tp = jnp.concatenate([jnp.zeros_like(t[:, :, :, :1]), t], axis=3)
        return jnp.concatenate([tp[:, :, :, :-1], tp[:, :, :, 1:]], axis=4)

    kb, vb = band(ks), band(vs)
    scores = jnp.einsum('bhrnid,bhrnjd->bhrnij', qs, kb).astype(jnp.float32) * (DIL_DH ** -0.5)
    i_loc = jnp.arange(DIL_BLOCK)[:, None]
    j_loc = jnp.arange(2 * DIL_BLOCK)[None, :]
    rel = i_loc + DIL_BLOCK - j_loc
    blk = jnp.arange(nb)[:, None, None]
    valid = (rel >= 0) & (rel <= w) & (blk * DIL_BLOCK + j_loc - DIL_BLOCK >= 0)
    alibi = -slopes[:, None, None] * (rel * r).astype(jnp.float32)[None]
    scores = jnp.where(valid[None, None, None], scores + alibi[None, :, None, None], -jnp.inf)
    m = jnp.max(scores, axis=-1, keepdims=True)
    p = jnp.exp(scores - m)
    z = jnp.sum(p, axis=-1, keepdims=True)
    out = jnp.einsum('bhrnij,bhrnjd->bhrnid', (p / z).astype(v.dtype), vb)
    lse = (m + jnp.log(z))[..., 0]
    out = out.reshape(B, H, r, Lp, dh)[:, :, :, :L].transpose(0, 1, 3, 2, 4).reshape(B, H, S, dh)
    lse = lse.reshape(B, H, r, Lp)[:, :, :, :L].transpose(0, 1, 3, 2).reshape(B, H, S)
    return out, lse


def dilated_mixture(q, k, v, slopes):
    outs, lses = [], []
    for window, dilation in DIL_CONFIGS:
        o, lse = dilated_branch(q, k, v, slopes, window, dilation)
        outs.append(o)
        lses.append(lse)
    wts = jax.nn.softmax(jnp.stack(lses, axis=0), axis=0)
    return jnp.einsum('cbhs,cbhsd->bhsd', wts.astype(q.dtype), jnp.stack(outs, axis=0))


def grouped_expert_ffn(ht, expert_id, gate, w_gate, w_up, w_down):
    T, D = ht.shape
    K = expert_id.shape[1]
    P = T * K
    flat_e = expert_id.reshape(P)
    flat_tok = jnp.arange(P, dtype=jnp.int32) // K
    order = jnp.argsort(flat_e)
    e_sorted = flat_e[order]
    counts = jnp.bincount(flat_e, length=N_EXPERTS)
    padded = ((counts + MOE_BLOCK - 1) // MOE_BLOCK) * MOE_BLOCK
    start_sorted = jnp.cumsum(counts) - counts
    end_padded = jnp.cumsum(padded)
    start_padded = end_padded - padded
    dest = start_padded[e_sorted] + (jnp.arange(P) - start_sorted[e_sorted])
    n_rows = P + N_EXPERTS * MOE_BLOCK
    n_blocks = n_rows // MOE_BLOCK
    buf = jnp.zeros((n_rows, D), ht.dtype).at[dest].set(ht[flat_tok[order]])
    block_expert = jnp.minimum(
        jnp.searchsorted(end_padded, jnp.arange(n_blocks) * MOE_BLOCK, side='right'), N_EXPERTS - 1)

    def block_ffn(args):
        xblk, e = args
        hid = jax.nn.silu(xblk @ w_gate[e]) * (xblk @ w_up[e])
        return hid @ w_down[e]

    yb = lax.map(block_ffn, (buf.reshape(n_blocks, MOE_BLOCK, D), block_expert))
    y_sorted = yb.reshape(n_rows, D)[dest]
    y_pairs = jnp.zeros((P, D), yb.dtype).at[order].set(y_sorted).reshape(T, K, D)
    return jnp.einsum('tkd,tk->td', y_pairs, gate.astype(y_pairs.dtype))


def hier_moe(ht, rc_w, rc_b, rf_w, rf_b, w_gate, w_up, w_down):
    coarse = (ht @ rc_w + rc_b).astype(jnp.float32)
    p_coarse = jax.nn.softmax(coarse, axis=-1)
    g_idx = jnp.argmax(coarse, axis=-1).astype(jnp.int32)
    p_group = jnp.take_along_axis(p_coarse, g_idx[:, None], axis=1)
    fine = (jnp.einsum('td,dge->tge', ht, rf_w) + rf_b).astype(jnp.float32)
    fine_sel = jnp.take_along_axis(fine, g_idx[:, None, None], axis=1)[:, 0]
    top_val, top_idx = lax.top_k(fine_sel, TOP_K_INNER)
    gate = p_group * jax.nn.softmax(top_val, axis=-1)
    expert_id = g_idx[:, None] * EXPERTS_PER_GROUP + top_idx.astype(jnp.int32)
    return grouped_expert_ffn(ht, expert_id, gate, w_gate, w_up, w_down)


def setup_inputs(seed: int = 0) -> dict:
    key = jax.random.key(seed)
    ks = jax.random.split(key, 20)
    f32 = jnp.float32

    def nrm(k, shape, scale):
        return jax.random.normal(k, shape, f32) * scale

    col_scale = jnp.asarray(np.concatenate(
        [np.full((sz,), DEEPNORM_BETA if is_v else 1.0, np.float32) for sz, is_v in zip(SPLIT_SIZES, SPLIT_IS_VALUE)]))
    L = DEPTH
    return {
        "x": nrm(ks[0], (BATCH, SEQ, D_MODEL), 1.0),
        "w_in": nrm(ks[1], (L, D_MODEL, PROJ_WIDTH), D_MODEL ** -0.5) * col_scale,
        "gla_gate_w2": nrm(ks[2], (L, GLA_GATE_RANK, GLA_KEY_WIDTH), GLA_GATE_RANK ** -0.5),
        "gla_gate_b": nrm(ks[3], (L, GLA_KEY_WIDTH), 0.1),
        "gla_norm_g": 1.0 + nrm(ks[4], (L, GLA_DV), 0.02),
        "dil_norm_g": 1.0 + nrm(ks[5], (L, DIL_DH), 0.02),
        "w_out": nrm(ks[6], (L, MIX_WIDTH, D_MODEL), MIX_WIDTH ** -0.5 * DEEPNORM_BETA),
        "ln1_g": 1.0 + nrm(ks[7], (L, D_MODEL), 0.02),
        "ln1_b": nrm(ks[8], (L, D_MODEL), 0.02),
        "router_coarse_w": nrm(ks[9], (L, D_MODEL, N_GROUPS), D_MODEL ** -0.5),
        "router_coarse_b": nrm(ks[10], (L, N_GROUPS), 0.01),
        "router_fine_w": nrm(ks[11], (L, D_MODEL, N_GROUPS, EXPERTS_PER_GROUP), D_MODEL ** -0.5),
        "router_fine_b": nrm(ks[12], (L, N_GROUPS, EXPERTS_PER_GROUP), 0.01),
        "expert_w_gate": nrm(ks[13], (L, N_EXPERTS, D_MODEL, D_FF_EXPERT), D_MODEL ** -0.5),
        "expert_w_up": nrm(ks[14], (L, N_EXPERTS, D_MODEL, D_FF_EXPERT), D_MODEL ** -0.5 * DEEPNORM_BETA),
        "expert_w_down": nrm(ks[15], (L, N_EXPERTS, D_FF_EXPERT, D_MODEL), D_FF_EXPERT ** -0.5 * DEEPNORM_BETA),
        "ln2_g": 1.0 + nrm(ks[16], (L, D_MODEL), 0.02),
        "ln2_b": nrm(ks[17], (L, D_MODEL), 0.02),
    }


def reference(x, w_in, gla_gate_w2, gla_gate_b, gla_norm_g, dil_norm_g, w_out, ln1_g, ln1_b,
              router_coarse_w, router_coarse_b, router_fine_w, router_fine_b,
              expert_w_gate, expert_w_up, expert_w_down, ln2_g, ln2_b):
    B, S, D = x.shape
    slopes = jnp.exp2(-8.0 * jnp.arange(1, DIL_HEADS + 1, dtype=jnp.float32) / DIL_HEADS)
    h = x
    for l in range(DEPTH):
        proj = jnp.einsum('bsd,dp->bsp', h, w_in[l])
        g_q, g_k, g_v, g_r, g_a, d_q, d_k, d_v = jnp.split(proj, SPLIT_POINTS, axis=-1)
        log_a = jax.nn.log_sigmoid((g_a @ gla_gate_w2[l] + gla_gate_b[l]).astype(jnp.float32)) / GLA_GATE_TEMP
        o_gla = gla_chunked(to_heads(g_q, GLA_HEADS) * (GLA_DK ** -0.5), to_heads(g_k, GLA_HEADS),
                            to_heads(g_v, GLA_HEADS), to_heads(log_a, GLA_HEADS))
        o_gla = from_heads(rms_norm(o_gla, gla_norm_g[l])) * jax.nn.silu(g_r)
        o_dil = dilated_mixture(to_heads(d_q, DIL_HEADS), to_heads(d_k, DIL_HEADS),
                                to_heads(d_v, DIL_HEADS), slopes)
        o_dil = from_heads(rms_norm(o_dil, dil_norm_g[l]))
        mix = jnp.einsum('bsm,md->bsd', jnp.concatenate([o_gla, o_dil], axis=-1), w_out[l])
        h = layer_norm(DEEPNORM_ALPHA * h + mix, ln1_g[l], ln1_b[l])
        ffn = hier_moe(h.reshape(B * S, D), router_coarse_w[l], router_coarse_b[l], router_fine_w[l],
                       router_fine_b[l], expert_w_gate[l], expert_w_up[l], expert_w_down[l])
        h = layer_norm(DEEPNORM_ALPHA * h + ffn.reshape(B, S, D), ln2_g[l], ln2_b[l])
    return h
```

```cpp
#include <hip/hip_runtime.h>
#include <stdint.h>
#include <cstdio>

typedef unsigned short us;
constexpr int BATCH = 4, SEQ = 4096, DM = 1024, T = BATCH * SEQ;
constexpr int PW = 3328;
constexpr int PROJ_W = 3088;
constexpr int C_GQ = 0, C_GK = 256, C_GV = 512, C_GR = 1024, C_DQ = 1536, C_DK = 2048, C_DV = 2560, C_GA = 3072;
constexpr int NE = 32, FF = 512;
constexpr float ALPHA = 1.189207115002721f;
constexpr float EPS = 1e-5f;

constexpr size_t MiB = 1u << 20;
constexpr size_t OFF_CTL = 0;
constexpr size_t OFF_LIST = 1 * MiB;
constexpr size_t OFF_GATE = 3 * MiB;
constexpr size_t OFF_EID = OFF_GATE + 128 * 1024;
constexpr size_t OFF_STAT = OFF_EID + 128 * 1024;
constexpr size_t OFF_A = 118 * MiB;
constexpr size_t OFF_PROJ = 150 * MiB;
constexpr size_t OFF_H = 150 * MiB;
constexpr size_t OFF_Y = 192 * MiB;
constexpr int CW_CNT = 1024;
constexpr int CW_BASE = 1088;

__device__ __forceinline__ us f2bf(float f) { unsigned u = __float_as_uint(f); u += 0x7fffu + ((u >> 16) & 1u); return (us)(u >> 16); }
__device__ __forceinline__ float bf2f(us b) { return __uint_as_float(((unsigned)b) << 16); }
__device__ __forceinline__ float wave_sum(float v) {
#pragma unroll
  for (int o = 1; o < 64; o <<= 1) v += __shfl_xor(v, o);
  return v;
}
__device__ __forceinline__ int perm_col_to_orig(int c) { return c < 1536 ? c : (c < 3072 ? c + 16 : c - 3072 + 1536); }

template <class AF, class BF>
__device__ __forceinline__ void nv_tile(int K, AF aload, BF bload, float (&acc)[4][4], float* sA, float* sB) {
  const int tid = threadIdx.x, tx = tid & 15, ty = tid >> 4;
  for (int k0 = 0; k0 < K; k0 += 16) {
#pragma unroll
    for (int i = 0; i < 4; ++i) { const int idx = tid + i * 256; const int r = idx >> 4, kk = idx & 15; sA[kk * 68 + r] = aload(r, k0 + kk); }
#pragma unroll
    for (int i = 0; i < 4; ++i) { const int idx = tid + i * 256; const int kk = idx >> 6, c = idx & 63; sB[kk * 68 + c] = bload(k0 + kk, c); }
    __syncthreads();
#pragma unroll
    for (int kk = 0; kk < 16; ++kk) {
      float a[4], b[4];
#pragma unroll
      for (int i = 0; i < 4; ++i) { a[i] = sA[kk * 68 + ty * 4 + i]; b[i] = sB[kk * 68 + tx * 4 + i]; }
#pragma unroll
      for (int i = 0; i < 4; ++i)
#pragma unroll
        for (int j = 0; j < 4; ++j) acc[i][j] = fmaf(a[i], b[j], acc[i][j]);
    }
    __syncthreads();
  }
}
#define ZERO_ACC(acc) _Pragma("unroll") for (int i_ = 0; i_ < 4; ++i_) _Pragma("unroll") for (int j_ = 0; j_ < 4; ++j_) acc[i_][j_] = 0.f

__global__ void __launch_bounds__(256) nv_proj(const float* __restrict__ x, const float* __restrict__ w_in, us* __restrict__ proj) {
  __shared__ float sA[16 * 68], sB[16 * 68];
  const int m0 = blockIdx.x * 64, n0 = blockIdx.y * 64;
  float acc[4][4]; ZERO_ACC(acc);
  nv_tile(DM, [&](int r, int k) { return x[(size_t)(m0 + r) * DM + k]; },
          [&](int k, int c) { const int cc = n0 + c; return cc < PROJ_W ? w_in[(size_t)k * PROJ_W + perm_col_to_orig(cc)] : 0.f; }, acc, sA, sB);
  const int tx = threadIdx.x & 15, ty = threadIdx.x >> 4;
#pragma unroll
  for (int i = 0; i < 4; ++i)
#pragma unroll
    for (int j = 0; j < 4; ++j) proj[(size_t)(m0 + ty * 4 + i) * PW + n0 + tx * 4 + j] = f2bf(acc[i][j]);
}

__global__ void __launch_bounds__(128) nv_gla(const us* __restrict__ proj, const float* __restrict__ w2, const float* __restrict__ gb,
                                              const float* __restrict__ gng, us* __restrict__ mix) {
  const int bh = blockIdx.x, b = bh >> 2, h = bh & 3, e = threadIdx.x;
  __shared__ float sq[64], sk[64], sa[64], sred[2];
  float S[64];
#pragma unroll
  for (int d = 0; d < 64; ++d) S[d] = 0.f;
  const float g = gng[e];
  for (int t = 0; t < SEQ; ++t) {
    const us* row = proj + (size_t)(b * SEQ + t) * PW;
    if (e < 64) {
      const int d = e; float z = gb[h * 64 + d];
#pragma unroll
      for (int r = 0; r < 16; ++r) z = fmaf(bf2f(row[C_GA + r]), w2[r * 256 + h * 64 + d], z);
      const float ls = fminf(z, 0.f) - log1pf(expf(-fabsf(z)));
      sa[d] = expf(ls * (1.0f / 16.0f));
      sq[d] = bf2f(row[C_GQ + h * 64 + d]) * 0.125f;
      sk[d] = bf2f(row[C_GK + h * 64 + d]);
    }
    __syncthreads();
    const float v = bf2f(row[C_GV + h * 128 + e]);
    float o = 0.f;
#pragma unroll
    for (int d = 0; d < 64; ++d) { S[d] = fmaf(sa[d], S[d], sk[d] * v); o = fmaf(sq[d], S[d], o); }
    const float ss = wave_sum(o * o);
    if ((e & 63) == 0) sred[e >> 6] = ss;
    __syncthreads();
    const float ms = (sred[0] + sred[1]) * (1.0f / 128.0f);
    const float gr = bf2f(row[C_GR + h * 128 + e]);
    const float outv = o * rsqrtf(ms + EPS) * g * (gr / (1.0f + expf(-gr)));
    mix[(size_t)(b * SEQ + t) * DM + h * 128 + e] = f2bf(outv);
    __syncthreads();
  }
}

__global__ void __launch_bounds__(256) nv_dil(const us* __restrict__ proj, const float* __restrict__ dng, us* __restrict__ mix) {
  const int idx = blockIdx.x * 256 + threadIdx.x; const int h = idx & 7, tok = idx >> 3, b = tok / SEQ, t = tok % SEQ;
  float q[64];
  { const us* qp = proj + (size_t)tok * PW + C_DQ + h * 64;
#pragma unroll
    for (int d = 0; d < 64; ++d) q[d] = bf2f(qp[d]); }
  const float slope = exp2f(-(float)(h + 1));
  float acc[64];
#pragma unroll
  for (int d = 0; d < 64; ++d) acc[d] = 0.f;
  float M = -INFINITY, W = 0.f;
  for (int c = 0; c < 3; ++c) {
    const int r = (c == 0) ? 1 : (c == 1 ? 4 : 16);
    float o[64];
#pragma unroll
    for (int d = 0; d < 64; ++d) o[d] = 0.f;
    float m = -INFINITY, z = 0.f;
    for (int mm = 0; mm <= 128; ++mm) {
      const int tk = t - mm * r; if (tk < 0) break;
      const us* kp = proj + (size_t)(b * SEQ + tk) * PW + C_DK + h * 64;
      const us* vp = proj + (size_t)(b * SEQ + tk) * PW + C_DV + h * 64;
      float s = 0.f;
#pragma unroll
      for (int d8 = 0; d8 < 8; ++d8) { const uint4 kv = ((const uint4*)kp)[d8]; const unsigned w[4] = {kv.x, kv.y, kv.z, kv.w};
#pragma unroll
        for (int j = 0; j < 4; ++j) { s = fmaf(q[d8 * 8 + 2 * j], __uint_as_float(w[j] << 16), s); s = fmaf(q[d8 * 8 + 2 * j + 1], __uint_as_float(w[j] & 0xffff0000u), s); } }
      s = s * 0.125f - slope * (float)(mm * r);
      const float mn = fmaxf(m, s), f = expf(m - mn), p = expf(s - mn);
      z = z * f + p;
#pragma unroll
      for (int d8 = 0; d8 < 8; ++d8) { const uint4 vv = ((const uint4*)vp)[d8]; const unsigned w[4] = {vv.x, vv.y, vv.z, vv.w};
#pragma unroll
        for (int j = 0; j < 4; ++j) { o[d8 * 8 + 2 * j] = fmaf(o[d8 * 8 + 2 * j], f, p * __uint_as_float(w[j] << 16)); o[d8 * 8 + 2 * j + 1] = fmaf(o[d8 * 8 + 2 * j + 1], f, p * __uint_as_float(w[j] & 0xffff0000u)); } }
      m = mn;
    }
    const float lse = m + logf(z), iz = 1.0f / z;
    const float Mn = fmaxf(M, lse), f = expf(M - Mn), p = expf(lse - Mn);
    W = W * f + p;
#pragma unroll
    for (int d = 0; d < 64; ++d) acc[d] = fmaf(acc[d], f, p * (o[d] * iz));
    M = Mn;
  }
  float ss = 0.f; const float iw = 1.0f / W;
#pragma unroll
  for (int d = 0; d < 64; ++d) { acc[d] *= iw; ss = fmaf(acc[d], acc[d], ss); }
  const float rs = rsqrtf(ss * (1.0f / 64.0f) + EPS);
  us* op = mix + (size_t)tok * DM + 512 + h * 64;
#pragma unroll
  for (int d = 0; d < 64; ++d) op[d] = f2bf(acc[d] * rs * dng[d]);
}

__global__ void __launch_bounds__(256) nv_outproj(const float* __restrict__ x, const us* __restrict__ mix, const float* __restrict__ w_out, float* __restrict__ y1) {
  __shared__ float sA[16 * 68], sB[16 * 68];
  const int m0 = blockIdx.x * 64, n0 = blockIdx.y * 64;
  float acc[4][4]; ZERO_ACC(acc);
  nv_tile(DM, [&](int r, int k) { return bf2f(mix[(size_t)(m0 + r) * DM + k]); },
          [&](int k, int c) { return w_out[(size_t)k * DM + n0 + c]; }, acc, sA, sB);
  const int tx = threadIdx.x & 15, ty = threadIdx.x >> 4;
#pragma unroll
  for (int i = 0; i < 4; ++i)
#pragma unroll
    for (int j = 0; j < 4; ++j) { const size_t o = (size_t)(m0 + ty * 4 + i) * DM + n0 + tx * 4 + j; y1[o] = fmaf(ALPHA, x[o], acc[i][j]); }
}

__global__ void __launch_bounds__(256) nv_ln1_router(const float* __restrict__ y1, const float* __restrict__ g1, const float* __restrict__ b1,
                                                     const float* __restrict__ rcw, const float* __restrict__ rcb, const float* __restrict__ rfw, const float* __restrict__ rfb,
                                                     us* __restrict__ h1b, float* __restrict__ stat, float* __restrict__ gate, int* __restrict__ eid,
                                                     unsigned* __restrict__ ctl, int* __restrict__ list) {
  const int lane = threadIdx.x & 63, tok = blockIdx.x * 4 + (threadIdx.x >> 6);
  const float* yr = y1 + (size_t)tok * DM;
  float v[16]; float s = 0.f;
#pragma unroll
  for (int j = 0; j < 16; ++j) { v[j] = yr[lane + 64 * j]; s += v[j]; }
  const float mean = wave_sum(s) * (1.0f / DM); float s2 = 0.f;
#pragma unroll
  for (int j = 0; j < 16; ++j) { const float d = v[j] - mean; s2 = fmaf(d, d, s2); }
  const float rstd = rsqrtf(wave_sum(s2) * (1.0f / DM) + EPS);
  float lc[4] = {0.f, 0.f, 0.f, 0.f};
  float lf[32];
#pragma unroll
  for (int i = 0; i < 32; ++i) lf[i] = 0.f;
#pragma unroll
  for (int j = 0; j < 16; ++j) {
    const int k = lane + 64 * j;
    const float hv = (v[j] - mean) * rstd * g1[k] + b1[k];
    v[j] = hv;
    h1b[(size_t)tok * DM + k] = f2bf(hv);
#pragma unroll
    for (int i = 0; i < 4; ++i) lc[i] = fmaf(hv, rcw[k * 4 + i], lc[i]);
#pragma unroll
    for (int i = 0; i < 32; ++i) lf[i] = fmaf(hv, rfw[k * 32 + i], lf[i]);
  }
#pragma unroll
  for (int i = 0; i < 4; ++i) lc[i] = wave_sum(lc[i]) + rcb[i];
#pragma unroll
  for (int i = 0; i < 32; ++i) lf[i] = wave_sum(lf[i]) + rfb[i];
  if (lane == 0) {
    stat[tok * 2] = mean; stat[tok * 2 + 1] = rstd;
    int gi = 0; float mx = lc[0];
#pragma unroll
    for (int i = 1; i < 4; ++i) if (lc[i] > mx) { mx = lc[i]; gi = i; }
    float den = 0.f;
#pragma unroll
    for (int i = 0; i < 4; ++i) den += expf(lc[i] - mx);
    const float pg = 1.0f / den;
    float f8[8];
#pragma unroll
    for (int i = 0; i < 8; ++i) { float val = lf[i];
#pragma unroll
      for (int g = 1; g < 4; ++g) val = (gi == g) ? lf[g * 8 + i] : val; f8[i] = val; }
    int i0 = 0; float v0 = f8[0];
#pragma unroll
    for (int i = 1; i < 8; ++i) if (f8[i] > v0) { v0 = f8[i]; i0 = i; }
    int i1 = -1; float v1 = -INFINITY;
#pragma unroll
    for (int i = 0; i < 8; ++i) if (i != i0 && f8[i] > v1) { v1 = f8[i]; i1 = i; }
    const float e1 = expf(v1 - v0), g0 = pg / (1.0f + e1), g1v = pg * e1 / (1.0f + e1);
    const int ex0 = gi * 8 + i0, ex1 = gi * 8 + i1;
    gate[tok * 2] = g0; gate[tok * 2 + 1] = g1v; eid[tok * 2] = ex0; eid[tok * 2 + 1] = ex1;
    const unsigned p0 = atomicAdd(&ctl[CW_CNT + ex0], 1u); list[ex0 * T + p0] = tok * 2;
    const unsigned p1 = atomicAdd(&ctl[CW_CNT + ex1], 1u); list[ex1 * T + p1] = tok * 2 + 1;
  }
}
__global__ void nv_scan(unsigned* ctl) {
  if (threadIdx.x == 0) { unsigned acc = 0; for (int e = 0; e < NE; ++e) { ctl[CW_BASE + e] = acc; acc += (ctl[CW_CNT + e] + 255u) & ~255u; } ctl[CW_BASE + NE] = acc; }
}

__global__ void __launch_bounds__(256) nv_ffn1(const us* __restrict__ h1b, const float* __restrict__ wg, const float* __restrict__ wu,
                                               const unsigned* __restrict__ ctl, const int* __restrict__ list, us* __restrict__ Hbuf) {
  __shared__ float sA[16 * 68], sB[16 * 68];
  const int e = blockIdx.z, m0 = blockIdx.x * 64, n0 = blockIdx.y * 64;
  const int cnt = (int)ctl[CW_CNT + e]; if (m0 >= cnt) return;
  const int base = (int)ctl[CW_BASE + e];
  const int* le = list + e * T;
  const float* wge = wg + (size_t)e * DM * FF; const float* wue = wu + (size_t)e * DM * FF;
  float ag[4][4], au[4][4]; ZERO_ACC(ag); ZERO_ACC(au);
  auto aload = [&](int r, int k) { const int m = m0 + r; return m < cnt ? bf2f(h1b[(size_t)(le[m] >> 1) * DM + k]) : 0.f; };
  nv_tile(DM, aload, [&](int k, int c) { return wge[(size_t)k * FF + n0 + c]; }, ag, sA, sB);
  nv_tile(DM, aload, [&](int k, int c) { return wue[(size_t)k * FF + n0 + c]; }, au, sA, sB);
  const int tx = threadIdx.x & 15, ty = threadIdx.x >> 4;
#pragma unroll
  for (int i = 0; i < 4; ++i)
#pragma unroll
    for (int j = 0; j < 4; ++j) { const int m = m0 + ty * 4 + i; if (m < cnt) { const float gv = ag[i][j]; Hbuf[(size_t)(base + m) * FF + n0 + tx * 4 + j] = f2bf(gv / (1.0f + expf(-gv)) * au[i][j]); } }
}
__global__ void __launch_bounds__(256) nv_ffn2(const us* __restrict__ Hbuf, const float* __restrict__ wd, const unsigned* __restrict__ ctl, const int* __restrict__ list, us* __restrict__ Ybuf) {
  __shared__ float sA[16 * 68], sB[16 * 68];
  const int e = blockIdx.z, m0 = blockIdx.x * 64, n0 = blockIdx.y * 64;
  const int cnt = (int)ctl[CW_CNT + e]; if (m0 >= cnt) return;
  const int base = (int)ctl[CW_BASE + e];
  const int* le = list + e * T;
  const float* wde = wd + (size_t)e * FF * DM;
  float acc[4][4]; ZERO_ACC(acc);
  nv_tile(FF, [&](int r, int k) { const int m = m0 + r; return m < cnt ? bf2f(Hbuf[(size_t)(base + m) * FF + k]) : 0.f; },
          [&](int k, int c) { return wde[(size_t)k * DM + n0 + c]; }, acc, sA, sB);
  const int tx = threadIdx.x & 15, ty = threadIdx.x >> 4;
#pragma unroll
  for (int i = 0; i < 4; ++i) { const int m = m0 + ty * 4 + i; if (m < cnt) { const int p = le[m];
#pragma unroll
      for (int j = 0; j < 4; ++j) Ybuf[(size_t)p * DM + n0 + tx * 4 + j] = f2bf(acc[i][j]); } }
}
__global__ void __launch_bounds__(256) nv_final(float* __restrict__ y1out, const float* __restrict__ stat, const float* __restrict__ g1, const float* __restrict__ b1,
                                                const float* __restrict__ gate, const us* __restrict__ Ybuf, const float* __restrict__ g2, const float* __restrict__ b2) {
  const int lane = threadIdx.x & 63, tok = blockIdx.x * 4 + (threadIdx.x >> 6);
  float* yr = y1out + (size_t)tok * DM;
  const float mean = stat[tok * 2], rstd = stat[tok * 2 + 1], ga = gate[tok * 2], gb = gate[tok * 2 + 1];
  const us* y0 = Ybuf + (size_t)(tok * 2) * DM; const us* y1 = y0 + DM;
  float v[16]; float s = 0.f;
#pragma unroll
  for (int j = 0; j < 16; ++j) { const int k = lane + 64 * j; const float hv = (yr[k] - mean) * rstd * g1[k] + b1[k];
    v[j] = fmaf(ALPHA, hv, fmaf(ga, bf2f(y0[k]), gb * bf2f(y1[k]))); s += v[j]; }
  const float mu = wave_sum(s) * (1.0f / DM); float s2 = 0.f;
#pragma unroll
  for (int j = 0; j < 16; ++j) { const float d = v[j] - mu; s2 = fmaf(d, d, s2); }
  const float rs = rsqrtf(wave_sum(s2) * (1.0f / DM) + EPS);
#pragma unroll
  for (int j = 0; j < 16; ++j) { const int k = lane + 64 * j; yr[k] = (v[j] - mu) * rs * g2[k] + b2[k]; }
}

extern "C" void kernel_launch(void* const* d_in, const int* in_sizes, int n_in, void* d_out, int out_size, void* d_ws, size_t ws_size, hipStream_t stream) {
  const float* x = (const float*)d_in[0]; const float* w_in = (const float*)d_in[1]; const float* w2 = (const float*)d_in[2]; const float* gb = (const float*)d_in[3];
  const float* gng = (const float*)d_in[4]; const float* dng = (const float*)d_in[5]; const float* w_out = (const float*)d_in[6];
  const float* ln1g = (const float*)d_in[7]; const float* ln1b = (const float*)d_in[8]; const float* rcw = (const float*)d_in[9]; const float* rcb = (const float*)d_in[10];
  const float* rfw = (const float*)d_in[11]; const float* rfb = (const float*)d_in[12]; const float* wg = (const float*)d_in[13]; const float* wu = (const float*)d_in[14];
  const float* wd = (const float*)d_in[15]; const float* ln2g = (const float*)d_in[16]; const float* ln2b = (const float*)d_in[17];
  char* ws = (char*)d_ws; float* out = (float*)d_out;
  unsigned* ctl = (unsigned*)(ws + OFF_CTL); int* list = (int*)(ws + OFF_LIST); float* gate = (float*)(ws + OFF_GATE); int* eid = (int*)(ws + OFF_EID); float* stat = (float*)(ws + OFF_STAT);
  us* proj = (us*)(ws + OFF_PROJ); us* mix = (us*)(ws + OFF_A); us* h1b = (us*)(ws + OFF_A); us* Hbuf = (us*)(ws + OFF_H); us* Ybuf = (us*)(ws + OFF_Y);
  hipMemsetAsync(ws + OFF_CTL, 0, 1 * MiB, stream);
  nv_proj<<<dim3(T / 64, PW / 64), 256, 0, stream>>>(x, w_in, proj);
  nv_gla<<<16, 128, 0, stream>>>(proj, w2, gb, gng, mix);
  nv_dil<<<T * 8 / 256, 256, 0, stream>>>(proj, dng, mix);
  nv_outproj<<<dim3(T / 64, DM / 64), 256, 0, stream>>>(x, mix, w_out, out);
  nv_ln1_router<<<T / 4, 256, 0, stream>>>(out, ln1g, ln1b, rcw, rcb, rfw, rfb, h1b, stat, gate, eid, ctl, list);
  nv_scan<<<1, 64, 0, stream>>>(ctl);
  nv_ffn1<<<dim3(T / 64, FF / 64, NE), 256, 0, stream>>>(h1b, wg, wu, ctl, list, Hbuf);
  nv_ffn2<<<dim3(T / 64, DM / 64, NE), 256, 0, stream>>>(Hbuf, wd, ctl, list, Ybuf);
  nv_final<<<T / 4, 256, 0, stream>>>(out, stat, ln1g, ln1b, gate, Ybuf, ln2g, ln2b);
}
```

```cpp
#include <hip/hip_runtime.h>
#include <stdint.h>
#include <cstdio>

typedef unsigned short us;
constexpr int BATCH = 4, SEQ = 4096, DM = 1024, T = BATCH * SEQ;
constexpr int PW = 3328;
constexpr int PROJ_W = 3088;
constexpr int C_GQ = 0, C_GK = 256, C_GV = 512, C_GR = 1024, C_DQ = 1536, C_DK = 2048, C_DV = 2560, C_GA = 3072;
constexpr int NE = 32, FF = 512;
constexpr float ALPHA = 1.189207115002721f;
constexpr float EPS = 1e-5f;

constexpr size_t MiB = 1u << 20;
constexpr size_t OFF_CTL = 0;
constexpr size_t OFF_LIST = 1 * MiB;
constexpr size_t OFF_GATE = 3 * MiB;
constexpr size_t OFF_EID = OFF_GATE + 128 * 1024;
constexpr size_t OFF_STAT = OFF_EID + 128 * 1024;
constexpr size_t OFF_WIN = 13 * MiB;
constexpr size_t OFF_WOUT = 20 * MiB;
constexpr size_t OFF_WGU = 22 * MiB;
constexpr size_t OFF_WD = 86 * MiB;
constexpr size_t OFF_A = 118 * MiB;
constexpr size_t OFF_PROJ = 150 * MiB;
constexpr size_t OFF_H = 150 * MiB;
constexpr size_t OFF_Y = 192 * MiB;
constexpr int CW_CNT = 1024;
constexpr int CW_BASE = 1088;
constexpr int CW_BAR = 4096;

__device__ __forceinline__ us f2bf(float f) { unsigned u = __float_as_uint(f); u += 0x7fffu + ((u >> 16) & 1u); return (us)(u >> 16); }
__device__ __forceinline__ float bf2f(us b) { return __uint_as_float(((unsigned)b) << 16); }
__device__ __forceinline__ unsigned pk2(float lo, float hi) { return (unsigned)f2bf(lo) | ((unsigned)f2bf(hi) << 16); }
__device__ __forceinline__ float wave_sum(float v) {
#pragma unroll
  for (int o = 1; o < 64; o <<= 1) v += __shfl_xor(v, o);
  return v;
}
__device__ __forceinline__ int perm_col_to_orig(int c) { return c < 1536 ? c : (c < 3072 ? c + 16 : c - 3072 + 1536); }

#define LAS __attribute__((address_space(3)))
#define GAS __attribute__((address_space(1)))
typedef float f32x4 __attribute__((ext_vector_type(4)));
typedef short bf16x8 __attribute__((ext_vector_type(8)));
typedef unsigned u32x4 __attribute__((ext_vector_type(4)));
typedef unsigned u32x2 __attribute__((ext_vector_type(2)));
#define LDS_WAIT() asm volatile("s_waitcnt lgkmcnt(0)" ::: "memory")
#define VM_WAIT() asm volatile("s_waitcnt vmcnt(0)" ::: "memory")

namespace pg8 {
constexpr int BM = 256, BK = 64, HALF = 128, HTB = HALF * BK * 2, STAGE_BYTES = 8 * HTB, NXCD = 8, WGM = 8;
__host__ __device__ __forceinline__ int lds_byte(int r, int c) { const int st = (r >> 4) * 2 + (c >> 5), rr = r & 15, cc = c & 31, ob = rr * 64 + cc * 2; return st * 1024 + (ob ^ (((ob >> 9) & 1) << 5)); }
__host__ __device__ __forceinline__ void stage_rc(int b, int& R, int& C) { const int st = b / 1024, sb = b % 1024, swz = sb ^ (((sb >> 9) & 1) << 5); R = (st >> 1) * 16 + swz / 64; C = (st & 1) * 32 + (swz % 64) / 2; }
__host__ __device__ __forceinline__ int perm32(int rho) { const int n = rho >> 4, i = rho & 15; return 8 * (i >> 2) + 4 * n + (i & 3); }
__device__ __forceinline__ unsigned cvt_pk_bf16(float lo, float hi) { unsigned r; asm volatile("v_cvt_pk_bf16_f32 %0, %1, %2" : "=v"(r) : "v"(lo), "v"(hi)); return r; }

struct Unit { int pm, pn, e, cnt, base; };

template <class P, bool ALIGN_EPI>
__device__ __forceinline__ void gemm_phase(LAS unsigned char* lds, const P& pb) {
    const int tid = threadIdx.x, wid = __builtin_amdgcn_readfirstlane(tid >> 6), lane = tid & 63, wr = wid >> 2, wc = wid & 3, fr = lane & 15, fq = lane >> 4;
    const int K = pb.K, nt = K / BK;
    int Rr[2]; unsigned cc2[2], voffB[2];
#pragma unroll
    for (int i = 0; i < 2; ++i) { int R, C; stage_rc(tid * 16 + i * 8192, R, C); const int Rb = P::PERM ? ((R & ~31) + perm32(R & 31)) : R;
        Rr[i] = R; cc2[i] = (unsigned)C * 2u; voffB[i] = (unsigned)(Rb * K + C) * 2u; }
    const size_t kstep = (size_t)(BK * 2);
    const size_t hstepB = (size_t)HALF * K * 2;
    const unsigned ldsw = (unsigned)wid * 1024u;
    const int aoff = lds_byte(wr * 64 + fr, fq * 8), boff = lds_byte(wc * 32 + fr, fq * 8);
#define PG8_SA(b, h) (((b) * 2 + (h)) * HTB)
#define PG8_SB(b, h) ((4 + (b) * 2 + (h)) * HTB)
#define PG8_STAGE(bufoff, gbase, voff) do { _Pragma("unroll") for (int _i = 0; _i < 2; ++_i) \
        __builtin_amdgcn_global_load_lds((const unsigned*)((const char*)(gbase) + (voff)[_i]), (LAS unsigned*)(lds + (bufoff) + ldsw + _i * 8192), 16, 0, 0); } while (0)
#define PG8_LDA(dst, b, h) do { _Pragma("unroll") for (int m = 0; m < 4; ++m) _Pragma("unroll") for (int k = 0; k < 2; ++k) dst[m][k] = *(const LAS bf16x8*)(lds + PG8_SA(b, h) + aoff + m * 2048 + k * 1024); } while (0)
#define PG8_LDB(dst, b, h) do { _Pragma("unroll") for (int n = 0; n < 2; ++n) _Pragma("unroll") for (int k = 0; k < 2; ++k) dst[n][k] = *(const LAS bf16x8*)(lds + PG8_SB(b, h) + boff + n * 2048 + k * 1024); } while (0)
#define PG8_MMA(ai, bj, At, Bt) do { __builtin_amdgcn_s_setprio(1); _Pragma("unroll") for (int m = 0; m < 4; ++m) _Pragma("unroll") for (int n = 0; n < 2; ++n) _Pragma("unroll") for (int k = 0; k < 2; ++k) \
        acc[ai][bj][m][n] = __builtin_amdgcn_mfma_f32_16x16x32_bf16(Bt[n][k], At[m][k], acc[ai][bj][m][n], 0, 0, 0); __builtin_amdgcn_s_setprio(0); } while (0)
#define PG8_WAIT_V(n) asm volatile("s_waitcnt vmcnt(" #n ")" ::: "memory")
#define PG8_WAIT_L(n) asm volatile("s_waitcnt lgkmcnt(" #n ")" ::: "memory")
#define PG8_BAR __builtin_amdgcn_s_barrier()
#define PG8_SCHED __builtin_amdgcn_sched_barrier(0)
    Unit cur, nxt; int ui = 0;
    if (!pb.next(0, cur)) return;
    f32x4 acc[2][2][4][2];
#pragma unroll
    for (int a = 0; a < 2; ++a)
#pragma unroll
        for (int b = 0; b < 2; ++b)
#pragma unroll
            for (int m = 0; m < 4; ++m)
#pragma unroll
                for (int n = 0; n < 2; ++n) acc[a][b][m][n] = (f32x4){0.f, 0.f, 0.f, 0.f};
    bf16x8 At[4][2], B0[2][2], B1[2][2];
    unsigned va[2][2], vn[2][2];
#pragma unroll
    for (int h = 0; h < 2; ++h)
#pragma unroll
        for (int i = 0; i < 2; ++i) va[h][i] = pb.arow(cur, h * HALF + Rr[i]) + cc2[i];
    const char* const Ab = (const char*)pb.A;
    const char* cB = pb.bbase(cur);
    PG8_STAGE(PG8_SB(0, 0), cB, voffB); PG8_STAGE(PG8_SB(0, 1), cB + hstepB, voffB); PG8_STAGE(PG8_SA(0, 0), Ab, va[0]); PG8_STAGE(PG8_SA(0, 1), Ab, va[1]);
    if (wr == 1) PG8_BAR;
    PG8_WAIT_V(2); PG8_BAR;
    PG8_STAGE(PG8_SB(1, 0), cB + kstep, voffB); PG8_STAGE(PG8_SA(1, 0), Ab + kstep, va[0]); PG8_STAGE(PG8_SB(1, 1), cB + hstepB + kstep, voffB);
    PG8_WAIT_V(6); PG8_BAR;
    for (;;) {
        const bool has_next = pb.next(ui + 1, nxt);
        const char* nB = has_next ? pb.bbase(nxt) : cB;
#pragma unroll
        for (int h = 0; h < 2; ++h)
#pragma unroll
            for (int i = 0; i < 2; ++i) vn[h][i] = has_next ? (pb.arow(nxt, h * HALF + Rr[i]) + cc2[i]) : va[h][i];
        for (int t = 0; t < nt; t += 2) {
            const bool last = (t == nt - 2);
            const char* a1 = Ab + (size_t)(t + 1) * kstep;
            const char* a2 = last ? Ab : Ab + (size_t)(t + 2) * kstep; const char* b2 = last ? nB : cB + (size_t)(t + 2) * kstep;
            const char* a3 = a2 + kstep; const char* b3 = b2 + kstep;
            unsigned v2[2][2];
#pragma unroll
            for (int h = 0; h < 2; ++h)
#pragma unroll
                for (int i = 0; i < 2; ++i) v2[h][i] = last ? vn[h][i] : va[h][i];
            PG8_LDB(B0, 0, 0); PG8_LDB(B1, 0, 1); PG8_SCHED; PG8_LDA(At, 0, 0); PG8_STAGE(PG8_SA(1, 1), a1, va[1]);
            PG8_WAIT_V(8); PG8_WAIT_L(0); PG8_BAR; PG8_MMA(0, 0, At, B0); PG8_MMA(0, 1, At, B1); PG8_BAR; PG8_SCHED;
            PG8_LDA(At, 0, 1); PG8_STAGE(PG8_SB(0, 0), b2, voffB); PG8_STAGE(PG8_SB(0, 1), b2 + hstepB, voffB); PG8_STAGE(PG8_SA(0, 0), a2, v2[0]);
            PG8_WAIT_V(8); PG8_WAIT_L(0); PG8_BAR; PG8_MMA(1, 0, At, B0); PG8_MMA(1, 1, At, B1); PG8_BAR; PG8_SCHED;
            PG8_LDB(B0, 1, 0); PG8_LDB(B1, 1, 1); PG8_SCHED; PG8_LDA(At, 1, 0); PG8_STAGE(PG8_SA(0, 1), a2, v2[1]);
            PG8_WAIT_V(8); PG8_WAIT_L(0); PG8_BAR; PG8_MMA(0, 0, At, B0); PG8_MMA(0, 1, At, B1); PG8_BAR; PG8_SCHED;
            PG8_LDA(At, 1, 1); PG8_STAGE(PG8_SB(1, 0), b3, voffB); PG8_STAGE(PG8_SB(1, 1), b3 + hstepB, voffB); PG8_STAGE(PG8_SA(1, 0), a3, v2[0]);
            PG8_WAIT_V(8); PG8_WAIT_L(0); PG8_BAR; PG8_MMA(1, 0, At, B0); PG8_MMA(1, 1, At, B1); PG8_BAR; PG8_SCHED;
        }
        if constexpr (ALIGN_EPI) { if (wr == 0) PG8_BAR; }
        pb.epi(acc, cur, wr, wc, fr, fq);
        if (!has_next) break;
#pragma unroll
        for (int a = 0; a < 2; ++a)
#pragma unroll
            for (int b = 0; b < 2; ++b)
#pragma unroll
                for (int m = 0; m < 4; ++m)
#pragma unroll
                    for (int n = 0; n < 2; ++n) acc[a][b][m][n] = (f32x4){0.f, 0.f, 0.f, 0.f};
        cur = nxt; cB = nB; ++ui;
#pragma unroll
        for (int h = 0; h < 2; ++h)
#pragma unroll
            for (int i = 0; i < 2; ++i) va[h][i] = vn[h][i];
        if constexpr (ALIGN_EPI) { if (wr == 1) PG8_BAR; }
    }
    PG8_WAIT_V(0);
    if constexpr (!ALIGN_EPI) { if (wr == 0) PG8_BAR; }
    PG8_BAR;
#undef PG8_SA
#undef PG8_SB
#undef PG8_STAGE
#undef PG8_LDA
#undef PG8_LDB
#undef PG8_MMA
#undef PG8_WAIT_V
#undef PG8_WAIT_L
#undef PG8_BAR
#undef PG8_SCHED
}

__device__ __forceinline__ bool dense_next(int i, int G, int c, int nM, int nN, Unit& u) {
    const int nwg = nM * nN; const long L = (long)i * G + c; if (L >= nwg) return false;
    int wgid = (int)L; { const int q = nwg / NXCD, r = nwg % NXCD, xcd = wgid % NXCD, off = wgid / NXCD; wgid = (xcd < r ? xcd * (q + 1) : r * (q + 1) + (xcd - r) * q) + off; }
    const int nig = WGM * nN, gid = wgid / nig, fm = gid * WGM, gsz = (nM - fm) < WGM ? (nM - fm) : WGM;
    u.pm = fm + ((wgid % nig) % gsz); u.pn = (wgid % nig) / gsz; u.e = 0; u.cnt = 0; u.base = 0; return true;
}
}

struct ProbProj {
    static constexpr bool PERM = true;
    const us* A; const us* Bt; us* O; int K, G, c;
    __device__ __forceinline__ bool next(int i, pg8::Unit& u) const { return pg8::dense_next(i, G, c, T / 256, PW / 256, u); }
    __device__ __forceinline__ unsigned arow(const pg8::Unit& u, int r) const { return (unsigned)(u.pm * 256 + r) * (unsigned)(DM * 2); }
    __device__ __forceinline__ const char* bbase(const pg8::Unit& u) const { return (const char*)Bt + (size_t)u.pn * 256 * DM * 2; }
    __device__ __forceinline__ void epi(const f32x4 (&acc)[2][2][4][2], const pg8::Unit& u, int wr, int wc, int fr, int fq) const {
        const int row0 = u.pm * 256 + wr * 64 + fr, col0 = u.pn * 256 + wc * 32 + 8 * fq;
#pragma unroll
        for (int ai = 0; ai < 2; ++ai)
#pragma unroll
            for (int m = 0; m < 4; ++m) { us* rowp = O + (size_t)(row0 + ai * 128 + m * 16) * PW + col0;
#pragma unroll
                for (int bj = 0; bj < 2; ++bj) { const f32x4 v0 = acc[ai][bj][m][0], v1 = acc[ai][bj][m][1];
                    u32x4 w; w.x = pg8::cvt_pk_bf16(v0[0], v0[1]); w.y = pg8::cvt_pk_bf16(v0[2], v0[3]); w.z = pg8::cvt_pk_bf16(v1[0], v1[1]); w.w = pg8::cvt_pk_bf16(v1[2], v1[3]);
                    *(u32x4*)(rowp + bj * 128) = w; } }
    }
};
struct ProbOut {
    static constexpr bool PERM = false;
    const us* A; const us* Bt; const float* X; float* Y; int K, G, c;
    __device__ __forceinline__ bool next(int i, pg8::Unit& u) const { return pg8::dense_next(i, G, c, T / 256, DM / 256, u); }
    __device__ __forceinline__ unsigned arow(const pg8::Unit& u, int r) const { return (unsigned)(u.pm * 256 + r) * (unsigned)(DM * 2); }
    __device__ __forceinline__ const char* bbase(const pg8::Unit& u) const { return (const char*)Bt + (size_t)u.pn * 256 * DM * 2; }
    __device__ __forceinline__ void epi(const f32x4 (&acc)[2][2][4][2], const pg8::Unit& u, int wr, int wc, int fr, int fq) const {
        const int row0 = u.pm * 256 + wr * 64 + fr, col0 = u.pn * 256 + wc * 32 + 4 * fq;
#pragma unroll
        for (int ai = 0; ai < 2; ++ai)
#pragma unroll
            for (int m = 0; m < 4; ++m) { const size_t off = (size_t)(row0 + ai * 128 + m * 16) * DM + col0;
#pragma unroll
                for (int bj = 0; bj < 2; ++bj)
#pragma unroll
                    for (int n = 0; n < 2; ++n) { const f32x4 xv = *(const f32x4*)(X + off + bj * 128 + n * 16); *(f32x4*)(Y + off + bj * 128 + n * 16) = xv * ALPHA + acc[ai][bj][m][n]; } }
    }
};
struct GroupTab { const LAS int* tp; const LAS int* cn; const LAS int* bs; };
__device__ __forceinline__ bool grouped_next(int i, int G, int c, const GroupTab& gt, pg8::Unit& u) {
    const int ntile = gt.tp[NE]; const long L = (long)i * G + c; if (L >= (long)ntile * 4) return false;
    const int tau = (int)(L >> 2); u.pn = (int)(L & 3);
    int e = 0;
#pragma unroll 1
    for (int s = 16; s >= 1; s >>= 1) if (gt.tp[e + s] <= tau) e += s;
    u.e = e; u.pm = tau - gt.tp[e]; u.cnt = gt.cn[e]; u.base = gt.bs[e]; return true;
}
struct ProbFfn1 {
    static constexpr bool PERM = true;
    const us* A; const us* Bt; us* H; const int* list; int K, G, c; GroupTab gt;
    __device__ __forceinline__ bool next(int i, pg8::Unit& u) const { return grouped_next(i, G, c, gt, u); }
    __device__ __forceinline__ unsigned arow(const pg8::Unit& u, int r) const { int m = u.pm * 256 + r; m = m < u.cnt ? m : 0; const int p = list[u.e * T + m]; return (unsigned)(p >> 1) * (unsigned)(DM * 2); }
    __device__ __forceinline__ const char* bbase(const pg8::Unit& u) const { return (const char*)Bt + ((size_t)u.e * 1024 + (size_t)u.pn * 256) * DM * 2; }
    __device__ __forceinline__ void epi(const f32x4 (&acc)[2][2][4][2], const pg8::Unit& u, int wr, int wc, int fr, int fq) const {
        const int row0 = u.base + u.pm * 256 + wr * 64 + fr, col0 = u.pn * 128 + wc * 32 + 8 * fq;
#pragma unroll
        for (int ai = 0; ai < 2; ++ai)
#pragma unroll
            for (int m = 0; m < 4; ++m) { us* rowp = H + (size_t)(row0 + ai * 128 + m * 16) * FF + col0;
                float hv[8];
#pragma unroll
                for (int n = 0; n < 2; ++n)
#pragma unroll
                    for (int j = 0; j < 4; ++j) { const float g = acc[ai][0][m][n][j], uu = acc[ai][1][m][n][j]; hv[n * 4 + j] = g * __builtin_amdgcn_rcpf(1.0f + __expf(-g)) * uu; }
                u32x4 w; w.x = pg8::cvt_pk_bf16(hv[0], hv[1]); w.y = pg8::cvt_pk_bf16(hv[2], hv[3]); w.z = pg8::cvt_pk_bf16(hv[4], hv[5]); w.w = pg8::cvt_pk_bf16(hv[6], hv[7]);
                *(u32x4*)rowp = w; }
    }
};
struct ProbFfn2 {
    static constexpr bool PERM = true;
    const us* A; const us* Bt; us* Y; const int* list; int K, G, c; GroupTab gt;
    __device__ __forceinline__ bool next(int i, pg8::Unit& u) const { return grouped_next(i, G, c, gt, u); }
    __device__ __forceinline__ unsigned arow(const pg8::Unit& u, int r) const { return (unsigned)(u.base + u.pm * 256 + r) * (unsigned)(FF * 2); }
    __device__ __forceinline__ const char* bbase(const pg8::Unit& u) const { return (const char*)Bt + ((size_t)u.e * 1024 + (size_t)u.pn * 256) * FF * 2; }
    __device__ __forceinline__ void epi(const f32x4 (&acc)[2][2][4][2], const pg8::Unit& u, int wr, int wc, int fr, int fq) const {
        const int col0 = u.pn * 256 + wc * 32 + 8 * fq;
#pragma unroll
        for (int ai = 0; ai < 2; ++ai)
#pragma unroll
            for (int m = 0; m < 4; ++m) { const int mrow = u.pm * 256 + ai * 128 + wr * 64 + m * 16 + fr;
                if (mrow < u.cnt) { const int p = list[u.e * T + mrow]; us* rowp = Y + (size_t)p * DM + col0;
#pragma unroll
                    for (int bj = 0; bj < 2; ++bj) { const f32x4 v0 = acc[ai][bj][m][0], v1 = acc[ai][bj][m][1];
                        u32x4 w; w.x = pg8::cvt_pk_bf16(v0[0], v0[1]); w.y = pg8::cvt_pk_bf16(v0[2], v0[3]); w.z = pg8::cvt_pk_bf16(v1[0], v1[1]); w.w = pg8::cvt_pk_bf16(v1[2], v1[3]);
                        *(u32x4*)(rowp + bj * 128) = w; } } }
    }
};


typedef float f32x16 __attribute__((ext_vector_type(16)));
typedef short s16x4 __attribute__((ext_vector_type(4)));
typedef short v4i16_t __attribute__((ext_vector_type(4)));
typedef float f32x2_t __attribute__((ext_vector_type(2)));
typedef __bf16 bf16x2_t __attribute__((ext_vector_type(2)));
__device__ __forceinline__ unsigned cvtpk(float lo, float hi) { f32x2_t v = {lo, hi}; bf16x2_t b = __builtin_convertvector(v, bf16x2_t); return __builtin_bit_cast(unsigned, b); }
__device__ __forceinline__ s16x4 vtr(const LAS unsigned char* p) { return __builtin_bit_cast(s16x4, __builtin_amdgcn_ds_read_tr16_b64_v4i16((LAS v4i16_t*)p)); }
__device__ __forceinline__ int crow(int r, int hi) { return (r & 3) + 8 * (r >> 2) + 4 * hi; }
constexpr float LOG2E = 1.4426950408889634f, LN2 = 0.6931471805599453f;
constexpr int ATT_UNITS = 32 * 48;
constexpr size_t PART_LSE_OFF = (size_t)3 * T * 512 * 2;

__device__ __forceinline__ void attn_unit(LAS unsigned char* lds, const us* __restrict__ proj, us* __restrict__ part_o, float* __restrict__ part_lse, int u, int tid, int lane, int wave) {
    const int bh = u / 48, rem = u % 48, c = rem >> 4, sub = rem & 15;
    const int b = bh >> 3, h = bh & 7;
    const int r = (c == 0) ? 1 : (c == 1 ? 4 : 16);
    const int rho = (c == 0) ? 0 : (c == 1 ? (sub & 3) : sub);
    const int qb = (c == 0) ? sub : (c == 1 ? (sub >> 2) : 0);
    const int i0 = qb * 256, kb0 = i0 - 128;
    const us* pb = proj + (size_t)b * SEQ * PW;
    u32x4 st[12];
#pragma unroll
    for (int n = 0; n < 12; ++n) { const int id = tid + 512 * n; const int mat = id >= 3072 ? 1 : 0; const int rr = (id - mat * 3072) >> 3, cc = id & 7;
        int idx = kb0 + rr; idx = idx < 0 ? 0 : idx; const int pos = idx * r + rho;
        st[n] = *(const u32x4*)(pb + (size_t)pos * PW + (mat ? C_DV : C_DK) + h * 64 + cc * 8); }
    const int q = lane & 31, hi = lane >> 5;
    const int posq = (i0 + 32 * wave + q) * r + rho;
    bf16x8 qf[4];
#pragma unroll
    for (int d0 = 0; d0 < 4; ++d0) qf[d0] = *(const bf16x8*)(pb + (size_t)posq * PW + C_DQ + h * 64 + d0 * 16 + hi * 8);
#pragma unroll
    for (int n = 0; n < 12; ++n) { const int id = tid + 512 * n; const int mat = id >= 3072 ? 1 : 0; const int rr = (id - mat * 3072) >> 3, cc = id & 7;
        const int p = mat ? (cc ^ (((rr >> 1) & 1) << 2)) : (cc ^ ((rr >> 1) & 7));
        *(LAS u32x4*)(lds + mat * 49152 + rr * 128 + p * 16) = st[n]; }
    __syncthreads();
    f32x16 p[5];
#pragma unroll
    for (int t = 0; t < 5; ++t) {
        const int kr = 32 * (wave + t) + q;
        f32x16 acc;
#pragma unroll
        for (int i = 0; i < 16; ++i) acc[i] = 0.f;
#pragma unroll
        for (int d0 = 0; d0 < 4; ++d0) { const int cch = 2 * d0 + hi; const bf16x8 a = *(const LAS bf16x8*)(lds + kr * 128 + ((cch ^ ((kr >> 1) & 7)) * 16));
            acc = __builtin_amdgcn_mfma_f32_32x32x16_bf16(a, qf[d0], acc, 0, 0, 0); }
        p[t] = acc;
    }
    const float slope = exp2f(-(float)(h + 1)), SL = slope * (float)r * LOG2E, C2 = 0.125f * LOG2E;
    float m = -INFINITY;
#pragma unroll
    for (int t = 0; t < 5; ++t)
#pragma unroll
        for (int i = 0; i < 16; ++i) { const int k = crow(i, hi); const int rel = 128 + q - 32 * t - k;
            float v = fmaf(p[t][i], C2, -SL * (float)rel);
            bool valid = true; if (t == 0) valid = (k >= q); if (t == 4) valid = (k <= q); if (qb == 0) valid = valid && (wave + t >= 4);
            v = valid ? v : -INFINITY; p[t][i] = v; m = fmaxf(m, v); }
    m = fmaxf(m, __shfl_xor(m, 32));
    float l = 0.f;
#pragma unroll
    for (int t = 0; t < 5; ++t)
#pragma unroll
        for (int i = 0; i < 16; ++i) { const float e = __builtin_amdgcn_exp2f(p[t][i] - m); p[t][i] = e; l += e; }
    l += __shfl_xor(l, 32);
    f32x16 o[2];
#pragma unroll
    for (int i = 0; i < 16; ++i) { o[0][i] = 0.f; o[1][i] = 0.f; }
    const LAS unsigned char* vbase = lds + 49152;
    const int q4 = (lane & 15) >> 2, blk = (lane >> 4) & 1, p3 = lane & 3;
#pragma unroll
    for (int t = 0; t < 5; ++t)
#pragma unroll
        for (int s2 = 0; s2 < 2; ++s2) {
            u32x4 pw; pw.x = cvtpk(p[t][8 * s2 + 0], p[t][8 * s2 + 1]); pw.y = cvtpk(p[t][8 * s2 + 2], p[t][8 * s2 + 3]); pw.z = cvtpk(p[t][8 * s2 + 4], p[t][8 * s2 + 5]); pw.w = cvtpk(p[t][8 * s2 + 6], p[t][8 * s2 + 7]);
            const bf16x8 pbf = __builtin_bit_cast(bf16x8, pw);
            const int r0 = 32 * (wave + t) + 16 * s2 + 4 * hi + q4, r1 = r0 + 8;
#pragma unroll
            for (int db = 0; db < 2; ++db) { const int cch = db * 4 + 2 * blk + (p3 >> 1);
                const s16x4 lo = vtr(vbase + r0 * 128 + ((cch ^ (((r0 >> 1) & 1) << 2)) * 16) + 8 * (p3 & 1));
                const s16x4 hh = vtr(vbase + r1 * 128 + ((cch ^ (((r1 >> 1) & 1) << 2)) * 16) + 8 * (p3 & 1));
                const bf16x8 a = __builtin_shufflevector(lo, hh, 0, 1, 2, 3, 4, 5, 6, 7);
                o[db] = __builtin_amdgcn_mfma_f32_32x32x16_bf16(a, pbf, o[db], 0, 0, 0); }
        }
    const float il = 1.0f / l;
    const size_t tok = (size_t)b * SEQ + posq;
    if (hi == 0) part_lse[((size_t)c * T + tok) * 8 + h] = (m + __log2f(l)) * LN2;
    us* op = part_o + ((size_t)c * T + tok) * 512 + h * 64;
#pragma unroll
    for (int db = 0; db < 2; ++db)
#pragma unroll
        for (int g = 0; g < 4; ++g) { uint2 w; w.x = cvtpk(o[db][4 * g] * il, o[db][4 * g + 1] * il); w.y = cvtpk(o[db][4 * g + 2] * il, o[db][4 * g + 3] * il);
            *(uint2*)(op + db * 32 + 8 * g + 4 * hi) = w; }
    __syncthreads();
}


constexpr int GL_QT = 0, GL_KT = 8192, GL_KH = 16384, GL_VC = 24576, GL_ST = 40960, GL_DEC = 57344, GL_W2 = 57600, GL_RED = 61696;
constexpr size_t OFF_GST = 4 * MiB, OFF_GDEC = 12 * MiB;

__device__ __forceinline__ bf16x8 tr_frag(const LAS unsigned char* base, int rowbytes, int r0, int r1, int cch, int sh0, int sh1, int off8) {
    const s16x4 lo = vtr(base + r0 * rowbytes + ((cch ^ sh0) * 16) + off8);
    const s16x4 hh = vtr(base + r1 * rowbytes + ((cch ^ sh1) * 16) + off8);
    return __builtin_shufflevector(lo, hh, 0, 1, 2, 3, 4, 5, 6, 7);
}

template <bool OUT>
__device__ __forceinline__ void gla_unit(LAS unsigned char* lds, const us* __restrict__ proj, const float* __restrict__ w2, const float* __restrict__ gb, const float* __restrict__ gng,
                                         float* __restrict__ gst, float* __restrict__ gdec, us* __restrict__ mix, int u, int tid, int lane, int wave) {
    const int bh = u >> 4, seg = u & 15, b = bh >> 2, h = bh & 3;
    const int eb = wave >> 1, ib = wave & 1, db = wave & 1;
    const int q = lane & 31, hi = lane >> 5, q4 = (lane & 15) >> 2, blk = (lane >> 4) & 1, p3 = lane & 3, off8 = 8 * (p3 & 1);
    LAS float* W2 = (LAS float*)(lds + GL_W2); LAS float* DEC = (LAS float*)(lds + GL_DEC); LAS float* RED = (LAS float*)(lds + GL_RED);
    for (int i = tid; i < 1024; i += 512) W2[i] = w2[(i >> 6) * 256 + h * 64 + (i & 63)];
    float bias[8];
#pragma unroll
    for (int dd = 0; dd < 8; ++dd) bias[dd] = gb[h * 64 + 8 * wave + dd];
    f32x16 S;
#pragma unroll
    for (int i = 0; i < 16; ++i) S[i] = 0.f;
    const int dl = db * 32 + q;
    if (OUT) {
        for (int sp = 0; sp < seg; ++sp) { const int pu = bh * 16 + sp; const float dcy = gdec[pu * 64 + dl]; const float* sl = gst + ((size_t)pu * 8 + wave) * 1024;
#pragma unroll
            for (int i = 0; i < 16; ++i) S[i] = fmaf(S[i], dcy, sl[i * 64 + lane]); }
#pragma unroll
        for (int g = 0; g < 4; ++g) { u32x2 w; w.x = cvtpk(S[4 * g], S[4 * g + 1]); w.y = cvtpk(S[4 * g + 2], S[4 * g + 3]);
            *(LAS u32x2*)(lds + GL_ST + dl * 256 + (((eb * 4 + g) ^ ((dl & 3) << 2)) * 16) + 8 * hi) = w; }
    }
    float lsum[8];
#pragma unroll
    for (int dd = 0; dd < 8; ++dd) lsum[dd] = 0.f;
    __syncthreads();
    for (int ch = 0; ch < 4; ++ch) {
        const int t0 = seg * 256 + ch * 64;
        {
            const us* row = proj + (size_t)(b * SEQ + t0 + lane) * PW;
            const u32x4 g0 = *(const u32x4*)(row + C_GA), g1 = *(const u32x4*)(row + C_GA + 8);
            const unsigned gw_[8] = {g0.x, g0.y, g0.z, g0.w, g1.x, g1.y, g1.z, g1.w};
            float z[8];
#pragma unroll
            for (int dd = 0; dd < 8; ++dd) z[dd] = bias[dd];
#pragma unroll
            for (int r2 = 0; r2 < 8; ++r2) { const float ga0 = __uint_as_float(gw_[r2] << 16), ga1 = __uint_as_float(gw_[r2] & 0xffff0000u);
                const f32x4 wa = *(const LAS f32x4*)(W2 + (2 * r2) * 64 + 8 * wave), wb = *(const LAS f32x4*)(W2 + (2 * r2) * 64 + 8 * wave + 4);
                const f32x4 wc = *(const LAS f32x4*)(W2 + (2 * r2 + 1) * 64 + 8 * wave), wd_ = *(const LAS f32x4*)(W2 + (2 * r2 + 1) * 64 + 8 * wave + 4);
#pragma unroll
                for (int j = 0; j < 4; ++j) { z[j] = fmaf(ga0, wa[j], z[j]); z[4 + j] = fmaf(ga0, wb[j], z[4 + j]); z[j] = fmaf(ga1, wc[j], z[j]); z[4 + j] = fmaf(ga1, wd_[j], z[4 + j]); } }
            float Lc[8], Ll[8];
#pragma unroll
            for (int dd = 0; dd < 8; ++dd) { const float zz = z[dd]; float la = (fminf(zz, 0.f) - __logf(1.0f + __expf(-fabsf(zz)))) * (1.0f / 16.0f);
#pragma unroll
                for (int off = 1; off < 64; off <<= 1) { const float tt = __shfl_up(la, off); la += (lane >= off) ? tt : 0.f; }
                Lc[dd] = la; Ll[dd] = __shfl(la, 63); lsum[dd] += Ll[dd]; }
            const u32x4 kv = *(const u32x4*)(row + C_GK + h * 64 + 8 * wave);
            const unsigned kw[4] = {kv.x, kv.y, kv.z, kv.w};
            float kf[8];
#pragma unroll
            for (int j = 0; j < 4; ++j) { kf[2 * j] = __uint_as_float(kw[j] << 16); kf[2 * j + 1] = __uint_as_float(kw[j] & 0xffff0000u); }
            { u32x4 w; float t8[8];
#pragma unroll
              for (int dd = 0; dd < 8; ++dd) t8[dd] = kf[dd] * __expf(Ll[dd] - Lc[dd]);
              w.x = cvtpk(t8[0], t8[1]); w.y = cvtpk(t8[2], t8[3]); w.z = cvtpk(t8[4], t8[5]); w.w = cvtpk(t8[6], t8[7]);
              *(LAS u32x4*)(lds + GL_KH + lane * 128 + ((wave ^ (((lane >> 1) & 1) << 2)) * 16)) = w; }
            if (OUT) {
                const u32x4 qv = *(const u32x4*)(row + C_GQ + h * 64 + 8 * wave);
                const unsigned qw[4] = {qv.x, qv.y, qv.z, qv.w};
                u32x4 wq, wk; float tq[8], tk[8];
#pragma unroll
                for (int j = 0; j < 4; ++j) { const float eA = __expf(Lc[2 * j]), eB = __expf(Lc[2 * j + 1]);
                    tq[2 * j] = __uint_as_float(qw[j] << 16) * 0.125f * eA; tq[2 * j + 1] = __uint_as_float(qw[j] & 0xffff0000u) * 0.125f * eB;
                    tk[2 * j] = kf[2 * j] * __expf(-Lc[2 * j]); tk[2 * j + 1] = kf[2 * j + 1] * __expf(-Lc[2 * j + 1]); }
                wq.x = cvtpk(tq[0], tq[1]); wq.y = cvtpk(tq[2], tq[3]); wq.z = cvtpk(tq[4], tq[5]); wq.w = cvtpk(tq[6], tq[7]);
                wk.x = cvtpk(tk[0], tk[1]); wk.y = cvtpk(tk[2], tk[3]); wk.z = cvtpk(tk[4], tk[5]); wk.w = cvtpk(tk[6], tk[7]);
                const int pz = (wave ^ ((lane >> 1) & 7)) * 16;
                *(LAS u32x4*)(lds + GL_QT + lane * 128 + pz) = wq; *(LAS u32x4*)(lds + GL_KT + lane * 128 + pz) = wk;
            }
            if (lane == 63) {
#pragma unroll
                for (int dd = 0; dd < 8; ++dd) DEC[8 * wave + dd] = __expf(Ll[dd]); }
            { const int j = tid >> 3, c0 = (tid & 7) * 2; const us* vr = proj + (size_t)(b * SEQ + t0 + j) * PW + C_GV + h * 128 + c0 * 8;
              const u32x4 v0 = *(const u32x4*)vr, v1 = *(const u32x4*)(vr + 8);
              *(LAS u32x4*)(lds + GL_VC + j * 256 + ((c0 ^ ((j & 3) << 2)) * 16)) = v0; *(LAS u32x4*)(lds + GL_VC + j * 256 + (((c0 + 1) ^ ((j & 3) << 2)) * 16)) = v1; }
        }
        __syncthreads();
        const int cve = eb * 4 + 2 * blk + (p3 >> 1);
        bf16x8 vf[2][2];
#pragma unroll
        for (int jb = 0; jb < 2; ++jb)
#pragma unroll
            for (int s2 = 0; s2 < 2; ++s2) { const int r0 = jb * 32 + 16 * s2 + 4 * hi + q4, r1 = r0 + 8;
                vf[jb][s2] = tr_frag(lds + GL_VC, 256, r0, r1, cve, (r0 & 3) << 2, (r1 & 3) << 2, off8); }
        f32x16 o;
        if (OUT) {
            const int irow = ib * 32 + q;
            bf16x8 qf[4];
#pragma unroll
            for (int ks = 0; ks < 4; ++ks) qf[ks] = *(const LAS bf16x8*)(lds + GL_QT + irow * 128 + (((2 * ks + hi) ^ ((irow >> 1) & 7)) * 16));
#pragma unroll
            for (int i = 0; i < 16; ++i) o[i] = 0.f;
#pragma unroll
            for (int ks = 0; ks < 4; ++ks) { const int r0 = 16 * ks + 8 * hi + q4, r1 = r0 + 4;
                const bf16x8 a = tr_frag(lds + GL_ST, 256, r0, r1, cve, (r0 & 3) << 2, (r1 & 3) << 2, off8);
                o = __builtin_amdgcn_mfma_f32_32x32x16_bf16(a, qf[ks], o, 0, 0, 0); }
#pragma unroll
            for (int jb = 0; jb < 2; ++jb) {
                if (jb <= ib) {
                    const int jrow = jb * 32 + q;
                    f32x16 at;
#pragma unroll
                    for (int i = 0; i < 16; ++i) at[i] = 0.f;
#pragma unroll
                    for (int ks = 0; ks < 4; ++ks) { const bf16x8 a = *(const LAS bf16x8*)(lds + GL_KT + jrow * 128 + (((2 * ks + hi) ^ ((jrow >> 1) & 7)) * 16));
                        at = __builtin_amdgcn_mfma_f32_32x32x16_bf16(a, qf[ks], at, 0, 0, 0); }
                    if (jb == ib) {
#pragma unroll
                        for (int i = 0; i < 16; ++i) at[i] = (crow(i, hi) > q) ? 0.f : at[i]; }
#pragma unroll
                    for (int s2 = 0; s2 < 2; ++s2) { u32x4 pw; pw.x = cvtpk(at[8 * s2], at[8 * s2 + 1]); pw.y = cvtpk(at[8 * s2 + 2], at[8 * s2 + 3]); pw.z = cvtpk(at[8 * s2 + 4], at[8 * s2 + 5]); pw.w = cvtpk(at[8 * s2 + 6], at[8 * s2 + 7]);
                        o = __builtin_amdgcn_mfma_f32_32x32x16_bf16(vf[jb][s2], __builtin_bit_cast(bf16x8, pw), o, 0, 0, 0); }
                }
            }
        }
        { const float dcy = DEC[dl];
#pragma unroll
          for (int i = 0; i < 16; ++i) S[i] *= dcy;
          const int ckd = db * 4 + 2 * blk + (p3 >> 1);
#pragma unroll
          for (int jb = 0; jb < 2; ++jb)
#pragma unroll
              for (int s2 = 0; s2 < 2; ++s2) { const int r0 = jb * 32 + 16 * s2 + 4 * hi + q4, r1 = r0 + 8;
                  const bf16x8 kb_ = tr_frag(lds + GL_KH, 128, r0, r1, ckd, ((r0 >> 1) & 1) << 2, ((r1 >> 1) & 1) << 2, off8);
                  S = __builtin_amdgcn_mfma_f32_32x32x16_bf16(vf[jb][s2], kb_, S, 0, 0, 0); } }
        if (OUT) {
            float ss = 0.f;
#pragma unroll
            for (int i = 0; i < 16; ++i) ss = fmaf(o[i], o[i], ss);
            ss += __shfl_xor(ss, 32);
            if (hi == 0) RED[(ib * 4 + eb) * 32 + q] = ss;
        }
        __syncthreads();
        if (OUT) {
            const float tot = RED[(ib * 4 + 0) * 32 + q] + RED[(ib * 4 + 1) * 32 + q] + RED[(ib * 4 + 2) * 32 + q] + RED[(ib * 4 + 3) * 32 + q];
            const float rs = rsqrtf(tot * (1.0f / 128.0f) + EPS);
            const size_t tok = (size_t)b * SEQ + t0 + ib * 32 + q;
#pragma unroll
            for (int g = 0; g < 4; ++g) { const int e0 = eb * 32 + 8 * g + 4 * hi;
                const uint2 gr = *(const uint2*)(proj + tok * PW + C_GR + h * 128 + e0); const f32x4 gn = *(const f32x4*)(gng + e0);
                const float r4[4] = {__uint_as_float(gr.x << 16), __uint_as_float(gr.x & 0xffff0000u), __uint_as_float(gr.y << 16), __uint_as_float(gr.y & 0xffff0000u)};
                float ov[4];
#pragma unroll
                for (int j = 0; j < 4; ++j) ov[j] = o[4 * g + j] * rs * gn[j] * (r4[j] / (1.0f + __expf(-r4[j])));
                uint2 w; w.x = cvtpk(ov[0], ov[1]); w.y = cvtpk(ov[2], ov[3]);
                *(uint2*)(mix + tok * DM + h * 128 + e0) = w; }
#pragma unroll
            for (int g = 0; g < 4; ++g) { u32x2 w; w.x = cvtpk(S[4 * g], S[4 * g + 1]); w.y = cvtpk(S[4 * g + 2], S[4 * g + 3]);
                *(LAS u32x2*)(lds + GL_ST + dl * 256 + (((eb * 4 + g) ^ ((dl & 3) << 2)) * 16) + 8 * hi) = w; }
        }
    }
    if (!OUT) {
        float* sl = gst + ((size_t)u * 8 + wave) * 1024;
#pragma unroll
        for (int i = 0; i < 16; ++i) sl[i * 64 + lane] = S[i];
        if (lane == 0) {
#pragma unroll
            for (int dd = 0; dd < 8; ++dd) gdec[u * 64 + 8 * wave + dd] = __expf(lsum[dd]); }
    }
    __syncthreads();
}

#define XB_TMO      128
#define XB_XCNT(j)  (256  + 64 * (j))
#define XB_XSUB(j)  (1280 + 64 * (j))
#define XB_XGEN(j)  (2304 + 64 * (j))
#define XB_TOP      3328
#define XB_TOPGEN   3392
#define XCD_BAR_WORDS 3456
#define XB_SPIN_CAP (1u << 18)
__device__ __forceinline__ unsigned xb_ld(unsigned* p)              { return __hip_atomic_load(p, __ATOMIC_RELAXED, __HIP_MEMORY_SCOPE_AGENT); }
__device__ __forceinline__ unsigned xb_add(unsigned* p, unsigned v) { return __hip_atomic_fetch_add(p, v, __ATOMIC_RELAXED, __HIP_MEMORY_SCOPE_AGENT); }
__device__ __forceinline__ unsigned xb_xcc_id() { return (unsigned)__builtin_amdgcn_s_getreg((3 << 11) | 20) & 0xFu; }
#define XB_SPIN(cond, bar) do { unsigned _sp = 0; while (cond) { __builtin_amdgcn_s_sleep(1); \
    if ((++_sp & 255u) == 0u) { if (xb_ld(&(bar)[XB_TMO])) break; if (_sp > XB_SPIN_CAP) { atomicAdd(&(bar)[XB_TMO], 1u); break; } } } } while (0)
struct XcdBarrier { unsigned* bar; unsigned x; volatile LAS unsigned* st; };
__device__ __forceinline__ XcdBarrier xcd_barrier_post(unsigned* bar, volatile LAS unsigned* st) {
    XcdBarrier b; b.bar = bar; b.x = xb_xcc_id(); b.st = st;
    if (threadIdx.x == 0) (void)xb_add(&bar[XB_XCNT(b.x)], 1u);
    return b;
}
__device__ __forceinline__ void xcd_barrier_complete(unsigned* bar, unsigned x, unsigned& nloc, unsigned& nx) {
    const unsigned G = gridDim.x * gridDim.y * gridDim.z;
    unsigned sum, cnt, mine, sp = 0u;
    for (;;) {
        sum = 0u; cnt = 0u; mine = 0u;
#pragma unroll
        for (unsigned j = 0; j < 16; ++j) { const unsigned c = xb_ld(&bar[XB_XCNT(j)]); sum += c; cnt += (c > 0u) ? 1u : 0u; mine = (j == x) ? c : mine; }
        if (sum == G) break;
        __builtin_amdgcn_s_sleep(1);
        if ((++sp & 255u) == 0u) { if (xb_ld(&bar[XB_TMO])) break; if (sp > XB_SPIN_CAP) { atomicAdd(&bar[XB_TMO], 1u); break; } }
    }
    nloc = mine > 0u ? mine : 1u; nx = cnt > 0u ? cnt : 1u;
}
__device__ __forceinline__ void xcd_barrier(const XcdBarrier& b) {
    asm volatile("s_waitcnt vmcnt(0)" ::: "memory");
    __syncthreads();
    if (threadIdx.x == 0) {
        unsigned* bar = b.bar;
        __builtin_amdgcn_s_waitcnt(0);
        unsigned nloc = b.st[0], nx = b.st[1];
        if (nloc == 0u) { xcd_barrier_complete(bar, b.x, nloc, nx); b.st[0] = nloc; b.st[1] = nx; }
        const unsigned old = xb_add(&bar[XB_XSUB(b.x)], 1u);
        const unsigned gen = old / nloc;
        if (old + 1u == (gen + 1u) * nloc) {
            __builtin_amdgcn_fence(__ATOMIC_RELEASE, "agent");
            asm volatile("s_waitcnt vmcnt(0)" ::: "memory");
            const unsigned og = xb_add(&bar[XB_TOP], 1u);
            const unsigned tg = og / nx;
            if (og + 1u == (tg + 1u) * nx) xb_add(&bar[XB_TOPGEN], 1u);
            else XB_SPIN(xb_ld(&bar[XB_TOPGEN]) == tg, bar);
            __builtin_amdgcn_fence(__ATOMIC_ACQUIRE, "agent");
            xb_add(&bar[XB_XGEN(b.x)], 1u);
            asm volatile("s_waitcnt vmcnt(0)" ::: "memory");
        } else {
            XB_SPIN(xb_ld(&bar[XB_XGEN(b.x)]) == gen, bar);
            __builtin_amdgcn_fence(__ATOMIC_ACQUIRE, "agent");
            asm volatile("s_waitcnt vmcnt(0)" ::: "memory");
        }
    }
    __syncthreads();
}

constexpr int NWAVES = 8;
constexpr int RING_BYTES = 131072;
constexpr int LDSCTL_OFF = RING_BYTES;
constexpr int LDS_BYTES = 147456;
constexpr int LC_BAR = 0, LC_TP = 16, LC_CN = 64, LC_BS = 96;

struct Args { const float* in[18]; float* out; unsigned char* ws; int ph_lo, ph_hi, li, pad; };

__device__ __forceinline__ void p0_tr_item(const float* src, int ldw, int nvalid, us* dst, int ldk, LAS float* scr, int lane) {
    const int c = lane & 31;
#pragma unroll 8
    for (int i = 0; i < 32; ++i) { const int kk = 2 * i + (lane >> 5); scr[kk * 33 + c] = (c < nvalid) ? src[(size_t)kk * ldw + c] : 0.f; }
    LDS_WAIT(); asm volatile("" ::: "memory");
    const int c8 = lane & 7;
#pragma unroll
    for (int j = 0; j < 4; ++j) { const int n = (lane >> 3) + 8 * j; const LAS float* s = scr + (8 * c8) * 33 + n;
        u32x4 o; o.x = pk2(s[0 * 33], s[1 * 33]); o.y = pk2(s[2 * 33], s[3 * 33]); o.z = pk2(s[4 * 33], s[5 * 33]); o.w = pk2(s[6 * 33], s[7 * 33]);
        *(u32x4*)(dst + (size_t)n * ldk + 8 * c8) = o; }
    LDS_WAIT(); asm volatile("" ::: "memory");
}

__global__ void __launch_bounds__(NWAVES * 64, 2) mk_fwd(Args args) {
    extern __shared__ __attribute__((aligned(16))) unsigned char lds_raw[];
    LAS unsigned char* lds = (LAS unsigned char*)lds_raw;
    volatile LAS unsigned* LC = (volatile LAS unsigned*)(lds + LDSCTL_OFF);
    const int tid = threadIdx.x, lane = tid & 63, wave = __builtin_amdgcn_readfirstlane(tid >> 6);
    const int G = gridDim.x; const int bx = blockIdx.x;
    const int vcu = (G % 8 == 0) ? (bx % 8) * (G / 8) + bx / 8 : bx;
    unsigned char* ws = args.ws;
    unsigned* ctl = (unsigned*)(ws + OFF_CTL);
    const float* x = args.in[0]; const float* w_in = args.in[1]; const float* w_out = args.in[6];
    const float* ln1g = args.in[7]; const float* ln1b = args.in[8]; const float* rcw = args.in[9]; const float* rcb = args.in[10];
    const float* rfw = args.in[11]; const float* rfb = args.in[12]; const float* wg = args.in[13]; const float* wu = args.in[14];
    const float* wd = args.in[15]; const float* ln2g = args.in[16]; const float* ln2b = args.in[17];
    float* out = args.out;
    int* list = (int*)(ws + OFF_LIST); float* gate = (float*)(ws + OFF_GATE); int* eid = (int*)(ws + OFF_EID); float* stat = (float*)(ws + OFF_STAT);
    us* w_inT = (us*)(ws + OFF_WIN); us* w_outT = (us*)(ws + OFF_WOUT); us* wguT = (us*)(ws + OFF_WGU); us* wdT = (us*)(ws + OFF_WD);
    us* slotA = (us*)(ws + OFF_A); us* proj = (us*)(ws + OFF_PROJ); us* Hbuf = (us*)(ws + OFF_H); us* Ybuf = (us*)(ws + OFF_Y);

    for (int u = tid; u < (LDS_BYTES - LDSCTL_OFF) / 4; u += NWAVES * 64) ((LAS unsigned*)(lds + LDSCTL_OFF))[u] = 0u;
    __syncthreads();
    XcdBarrier bar = xcd_barrier_post(ctl + CW_BAR + args.li * XCD_BAR_WORDS, LC + LC_BAR);
    const int lo = args.ph_lo, hi = args.ph_hi;
#define IN(k) (lo <= (k) && (k) < hi)
#define BOTH(k) (IN(k) && IN((k) + 1))
    const int gw = vcu * NWAVES + wave, NGW = G * NWAVES;

    if (IN(0)) {
        LAS float* scr = (LAS float*)(lds + wave * 16384);
        constexpr int I_IN = 16 * (PW / 32), I_OUT = 16 * 32, I_E = 768, NITEMS = I_IN + I_OUT + NE * I_E;
        for (int it = gw; it < NITEMS; it += NGW) {
            int r = it;
            if (r < I_IN) { const int kb = r / (PW / 32), nb = r % (PW / 32), n0 = nb * 32;
                int sc, nv; if (n0 < 1536) { sc = n0; nv = 32; } else if (n0 < 3072) { sc = n0 + 16; nv = 32; } else if (n0 == 3072) { sc = 1536; nv = 16; } else { sc = 0; nv = 0; }
                p0_tr_item(w_in + (size_t)kb * 64 * PROJ_W + sc, PROJ_W, nv, w_inT + (size_t)n0 * DM + kb * 64, DM, scr, lane); continue; }
            r -= I_IN;
            if (r < I_OUT) { const int kb = r >> 5, nb = r & 31;
                p0_tr_item(w_out + (size_t)kb * 64 * DM + nb * 32, DM, 32, w_outT + (size_t)nb * 32 * DM + kb * 64, DM, scr, lane); continue; }
            r -= I_OUT;
            const int e = r / I_E, q = r % I_E;
            if (q < 512) { const int up = q >> 8, qq = q & 255, kb = qq >> 4, fb = qq & 15, f0 = fb * 32;
                const float* src = (up ? wu : wg) + (size_t)e * DM * FF + (size_t)kb * 64 * FF + f0;
                us* dst = wguT + ((size_t)e * 1024 + (size_t)(256 * (f0 >> 7) + (f0 & 127) + (up ? 128 : 0))) * DM + kb * 64;
                p0_tr_item(src, FF, 32, dst, DM, scr, lane); }
            else { const int qq = q - 512, kb = qq >> 5, nb = qq & 31;
                p0_tr_item(wd + (size_t)e * FF * DM + (size_t)kb * 64 * DM + nb * 32, DM, 32, wdT + ((size_t)e * 1024 + (size_t)nb * 32) * FF + kb * 64, FF, scr, lane); }
        }
        for (int m = gw; m < T; m += NGW) {
            const f32x4* xr = (const f32x4*)(x + (size_t)m * DM) + lane; unsigned long long* o8 = (unsigned long long*)(slotA + (size_t)m * DM) + lane;
#pragma unroll
            for (int j = 0; j < 4; ++j) { const f32x4 v = xr[64 * j]; o8[64 * j] = (unsigned long long)pk2(v[0], v[1]) | ((unsigned long long)pk2(v[2], v[3]) << 32); }
        }
        if (BOTH(0)) xcd_barrier(bar);
    }
    if (IN(1)) {
        ProbProj pb{slotA, w_inT, proj, DM, G, bx};
        pg8::gemm_phase<ProbProj, true>(lds, pb);
        if (BOTH(1)) xcd_barrier(bar);
    }
    if (IN(2)) {
        us* part_o = (us*)out; float* part_lse = (float*)((char*)out + PART_LSE_OFF);
        for (int u = bx; u < 256; u += G) gla_unit<false>(lds, proj, args.in[2], args.in[3], args.in[4], (float*)(ws + OFF_GST), (float*)(ws + OFF_GDEC), slotA, u, tid, lane, wave);
        for (int u = bx; u < ATT_UNITS; u += G) attn_unit(lds, proj, part_o, part_lse, u, tid, lane, wave);
        if (BOTH(2)) xcd_barrier(bar);
    }
    if (IN(3)) {
        const us* part_o = (const us*)out; const float* part_lse = (const float*)((const char*)out + PART_LSE_OFF);
        for (int u = bx; u < 256; u += G) gla_unit<true>(lds, proj, args.in[2], args.in[3], args.in[4], (float*)(ws + OFF_GST), (float*)(ws + OFF_GDEC), slotA, u, tid, lane, wave);
        const float* dng = args.in[5];
        for (int tok = gw; tok < T; tok += NGW) {
            const int h = lane >> 3, d8 = lane & 7;
            float ls[3], mx = -INFINITY;
#pragma unroll
            for (int c = 0; c < 3; ++c) { ls[c] = part_lse[((size_t)c * T + tok) * 8 + h]; mx = fmaxf(mx, ls[c]); }
            float W = 0.f, o[8];
#pragma unroll
            for (int j = 0; j < 8; ++j) o[j] = 0.f;
#pragma unroll
            for (int c = 0; c < 3; ++c) { const float w = __expf(ls[c] - mx); W += w;
                const uint4 v = *(const uint4*)(part_o + ((size_t)c * T + tok) * 512 + h * 64 + d8 * 8); const unsigned ww[4] = {v.x, v.y, v.z, v.w};
#pragma unroll
                for (int j = 0; j < 4; ++j) { o[2 * j] = fmaf(w, __uint_as_float(ww[j] << 16), o[2 * j]); o[2 * j + 1] = fmaf(w, __uint_as_float(ww[j] & 0xffff0000u), o[2 * j + 1]); } }
            const float iw = 1.0f / W; float ss = 0.f;
#pragma unroll
            for (int j = 0; j < 8; ++j) { o[j] *= iw; ss = fmaf(o[j], o[j], ss); }
            ss += __shfl_xor(ss, 1); ss += __shfl_xor(ss, 2); ss += __shfl_xor(ss, 4);
            const float rs = rsqrtf(ss * (1.0f / 64.0f) + EPS);
            const f32x4 g0 = *(const f32x4*)(dng + d8 * 8), g1 = *(const f32x4*)(dng + d8 * 8 + 4);
            u32x4 w; w.x = pk2(o[0] * rs * g0[0], o[1] * rs * g0[1]); w.y = pk2(o[2] * rs * g0[2], o[3] * rs * g0[3]); w.z = pk2(o[4] * rs * g1[0], o[5] * rs * g1[1]); w.w = pk2(o[6] * rs * g1[2], o[7] * rs * g1[3]);
            *(u32x4*)(slotA + (size_t)tok * DM + 512 + h * 64 + d8 * 8) = w;
        }
        if (BOTH(3)) xcd_barrier(bar);
    }
    if (IN(4)) {
        ProbOut pb{slotA, w_outT, x, out, DM, G, bx};
        pg8::gemm_phase<ProbOut, false>(lds, pb);
        if (BOTH(4)) xcd_barrier(bar);
    }
    if (IN(5)) {
        for (int tok = gw; tok < T; tok += NGW) {
            const float* yr = out + (size_t)tok * DM;
            float s = 0.f;
#pragma unroll
            for (int j = 0; j < 16; ++j) s += yr[lane + 64 * j];
            const float mean = wave_sum(s) * (1.0f / DM); float s2 = 0.f;
#pragma unroll
            for (int j = 0; j < 16; ++j) { const float d = yr[lane + 64 * j] - mean; s2 = fmaf(d, d, s2); }
            const float rstd = rsqrtf(wave_sum(s2) * (1.0f / DM) + EPS);
            float lc[4] = {0.f, 0.f, 0.f, 0.f}; float lf[32];
#pragma unroll
            for (int i = 0; i < 32; ++i) lf[i] = 0.f;
#pragma unroll 2
            for (int j = 0; j < 16; ++j) {
                const int k = lane + 64 * j;
                const float hv = (yr[k] - mean) * rstd * ln1g[k] + ln1b[k];
                slotA[(size_t)tok * DM + k] = f2bf(hv);
                const f32x4 c4 = *(const f32x4*)(rcw + k * 4);
#pragma unroll
                for (int i = 0; i < 4; ++i) lc[i] = fmaf(hv, c4[i], lc[i]);
#pragma unroll
                for (int i4 = 0; i4 < 8; ++i4) { const f32x4 w4 = *(const f32x4*)(rfw + k * 32 + i4 * 4);
#pragma unroll
                    for (int i = 0; i < 4; ++i) lf[i4 * 4 + i] = fmaf(hv, w4[i], lf[i4 * 4 + i]); }
            }
#pragma unroll
            for (int i = 0; i < 4; ++i) lc[i] = wave_sum(lc[i]) + rcb[i];
#pragma unroll
            for (int i = 0; i < 32; ++i) lf[i] = wave_sum(lf[i]) + rfb[i];
            if (lane == 0) {
                stat[tok * 2] = mean; stat[tok * 2 + 1] = rstd;
                int gi = 0; float mx = lc[0];
#pragma unroll
                for (int i = 1; i < 4; ++i) if (lc[i] > mx) { mx = lc[i]; gi = i; }
                float den = 0.f;
#pragma unroll
                for (int i = 0; i < 4; ++i) den += expf(lc[i] - mx);
                const float pg = 1.0f / den;
                float f8[8];
#pragma unroll
                for (int i = 0; i < 8; ++i) { float val = lf[i];
#pragma unroll
                    for (int g = 1; g < 4; ++g) val = (gi == g) ? lf[g * 8 + i] : val; f8[i] = val; }
                int i0 = 0; float v0 = f8[0];
#pragma unroll
                for (int i = 1; i < 8; ++i) if (f8[i] > v0) { v0 = f8[i]; i0 = i; }
                int i1 = -1; float v1 = -INFINITY;
#pragma unroll
                for (int i = 0; i < 8; ++i) if (i != i0 && f8[i] > v1) { v1 = f8[i]; i1 = i; }
                const float e1 = expf(v1 - v0), g0 = pg / (1.0f + e1), g1v = pg * e1 / (1.0f + e1);
                const int ex0 = gi * 8 + i0, ex1 = gi * 8 + i1;
                gate[tok * 2] = g0; gate[tok * 2 + 1] = g1v; eid[tok * 2] = ex0; eid[tok * 2 + 1] = ex1;
                const unsigned p0 = atomicAdd(&ctl[CW_CNT + ex0], 1u); list[ex0 * T + p0] = tok * 2;
                const unsigned p1 = atomicAdd(&ctl[CW_CNT + ex1], 1u); list[ex1 * T + p1] = tok * 2 + 1;
            }
        }
        if (BOTH(5)) xcd_barrier(bar);
    }
    if (IN(6) || IN(7)) {
        if (tid == 0) { int tp = 0, bs = 0;
            for (int e = 0; e < NE; ++e) { const int cnt = (int)__hip_atomic_load(&ctl[CW_CNT + e], __ATOMIC_RELAXED, __HIP_MEMORY_SCOPE_AGENT); const int nt = (cnt + 255) >> 8;
                LC[LC_TP + e] = tp; LC[LC_CN + e] = cnt; LC[LC_BS + e] = bs; tp += nt; bs += nt * 256; }
            LC[LC_TP + NE] = tp; LC[LC_BS + NE] = bs; }
        __syncthreads();
    }
    const GroupTab gt{(const LAS int*)(lds + LDSCTL_OFF) + LC_TP, (const LAS int*)(lds + LDSCTL_OFF) + LC_CN, (const LAS int*)(lds + LDSCTL_OFF) + LC_BS};
    if (IN(6)) {
        ProbFfn1 pb{slotA, wguT, Hbuf, list, DM, G, bx, gt};
        pg8::gemm_phase<ProbFfn1, true>(lds, pb);
        if (BOTH(6)) xcd_barrier(bar);
    }
    if (IN(7)) {
        ProbFfn2 pb{Hbuf, wdT, Ybuf, list, FF, G, bx, gt};
        pg8::gemm_phase<ProbFfn2, true>(lds, pb);
        if (BOTH(7)) xcd_barrier(bar);
    }
    if (IN(8)) {
        for (int tok = gw; tok < T; tok += NGW) {
            float* yr = out + (size_t)tok * DM;
            const float mean = stat[tok * 2], rstd = stat[tok * 2 + 1], ga = gate[tok * 2], gb = gate[tok * 2 + 1];
            const us* y0 = Ybuf + (size_t)(tok * 2) * DM; const us* y1 = y0 + DM;
            float v[16]; float s = 0.f;
#pragma unroll
            for (int j = 0; j < 4; ++j) { const int k = lane * 4 + 256 * j; const f32x4 yv = *(const f32x4*)(yr + k), g4 = *(const f32x4*)(ln1g + k), b4 = *(const f32x4*)(ln1b + k);
                const uint2 a = *(const uint2*)(y0 + k), b = *(const uint2*)(y1 + k);
                const float ya[4] = {__uint_as_float(a.x << 16), __uint_as_float(a.x & 0xffff0000u), __uint_as_float(a.y << 16), __uint_as_float(a.y & 0xffff0000u)};
                const float yb[4] = {__uint_as_float(b.x << 16), __uint_as_float(b.x & 0xffff0000u), __uint_as_float(b.y << 16), __uint_as_float(b.y & 0xffff0000u)};
#pragma unroll
                for (int i = 0; i < 4; ++i) { const float hv = (yv[i] - mean) * rstd * g4[i] + b4[i]; v[j * 4 + i] = fmaf(ALPHA, hv, fmaf(ga, ya[i], gb * yb[i])); s += v[j * 4 + i]; } }
            const float mu = wave_sum(s) * (1.0f / DM); float s2 = 0.f;
#pragma unroll
            for (int j = 0; j < 16; ++j) { const float d = v[j] - mu; s2 = fmaf(d, d, s2); }
            const float rs = rsqrtf(wave_sum(s2) * (1.0f / DM) + EPS);
#pragma unroll
            for (int j = 0; j < 4; ++j) { const int k = lane * 4 + 256 * j; const f32x4 g4 = *(const f32x4*)(ln2g + k), b4 = *(const f32x4*)(ln2b + k); f32x4 o;
#pragma unroll
                for (int i = 0; i < 4; ++i) o[i] = (v[j * 4 + i] - mu) * rs * g4[i] + b4[i];
                *(f32x4*)(yr + k) = o; }
        }
    }
#undef IN
#undef BOTH
}

__global__ void __launch_bounds__(128) nv_gla(const us* __restrict__ proj, const float* __restrict__ w2, const float* __restrict__ gb,
                                              const float* __restrict__ gng, us* __restrict__ mix) {
  const int bh = blockIdx.x, b = bh >> 2, h = bh & 3, e = threadIdx.x;
  __shared__ float sq[64], sk[64], sa[64], sred[2];
  float S[64];
#pragma unroll
  for (int d = 0; d < 64; ++d) S[d] = 0.f;
  const float g = gng[e];
  for (int t = 0; t < SEQ; ++t) {
    const us* row = proj + (size_t)(b * SEQ + t) * PW;
    if (e < 64) {
      const int d = e; float z = gb[h * 64 + d];
#pragma unroll
      for (int r = 0; r < 16; ++r) z = fmaf(bf2f(row[C_GA + r]), w2[r * 256 + h * 64 + d], z);
      const float ls = fminf(z, 0.f) - log1pf(expf(-fabsf(z)));
      sa[d] = expf(ls * (1.0f / 16.0f));
      sq[d] = bf2f(row[C_GQ + h * 64 + d]) * 0.125f;
      sk[d] = bf2f(row[C_GK + h * 64 + d]);
    }
    __syncthreads();
    const float v = bf2f(row[C_GV + h * 128 + e]);
    float o = 0.f;
#pragma unroll
    for (int d = 0; d < 64; ++d) { S[d] = fmaf(sa[d], S[d], sk[d] * v); o = fmaf(sq[d], S[d], o); }
    const float ss = wave_sum(o * o);
    if ((e & 63) == 0) sred[e >> 6] = ss;
    __syncthreads();
    const float ms = (sred[0] + sred[1]) * (1.0f / 128.0f);
    const float gr = bf2f(row[C_GR + h * 128 + e]);
    const float outv = o * rsqrtf(ms + EPS) * g * (gr / (1.0f + expf(-gr)));
    mix[(size_t)(b * SEQ + t) * DM + h * 128 + e] = f2bf(outv);
    __syncthreads();
  }
}
__global__ void __launch_bounds__(256) nv_dil(const us* __restrict__ proj, const float* __restrict__ dng, us* __restrict__ mix) {
  const int idx = blockIdx.x * 256 + threadIdx.x; const int h = idx & 7, tok = idx >> 3, b = tok / SEQ, t = tok % SEQ;
  float q[64];
  { const us* qp = proj + (size_t)tok * PW + C_DQ + h * 64;
#pragma unroll
    for (int d = 0; d < 64; ++d) q[d] = bf2f(qp[d]); }
  const float slope = exp2f(-(float)(h + 1));
  float acc[64];
#pragma unroll
  for (int d = 0; d < 64; ++d) acc[d] = 0.f;
  float M = -INFINITY, W = 0.f;
  for (int c = 0; c < 3; ++c) {
    const int r = (c == 0) ? 1 : (c == 1 ? 4 : 16);
    float o[64];
#pragma unroll
    for (int d = 0; d < 64; ++d) o[d] = 0.f;
    float m = -INFINITY, z = 0.f;
    for (int mm = 0; mm <= 128; ++mm) {
      const int tk = t - mm * r; if (tk < 0) break;
      const us* kp = proj + (size_t)(b * SEQ + tk) * PW + C_DK + h * 64;
      const us* vp = proj + (size_t)(b * SEQ + tk) * PW + C_DV + h * 64;
      float s = 0.f;
#pragma unroll
      for (int d8 = 0; d8 < 8; ++d8) { const uint4 kv = ((const uint4*)kp)[d8]; const unsigned w[4] = {kv.x, kv.y, kv.z, kv.w};
#pragma unroll
        for (int j = 0; j < 4; ++j) { s = fmaf(q[d8 * 8 + 2 * j], __uint_as_float(w[j] << 16), s); s = fmaf(q[d8 * 8 + 2 * j + 1], __uint_as_float(w[j] & 0xffff0000u), s); } }
      s = s * 0.125f - slope * (float)(mm * r);
      const float mn = fmaxf(m, s), f = expf(m - mn), p = expf(s - mn);
      z = z * f + p;
#pragma unroll
      for (int d8 = 0; d8 < 8; ++d8) { const uint4 vv = ((const uint4*)vp)[d8]; const unsigned w[4] = {vv.x, vv.y, vv.z, vv.w};
#pragma unroll
        for (int j = 0; j < 4; ++j) { o[d8 * 8 + 2 * j] = fmaf(o[d8 * 8 + 2 * j], f, p * __uint_as_float(w[j] << 16)); o[d8 * 8 + 2 * j + 1] = fmaf(o[d8 * 8 + 2 * j + 1], f, p * __uint_as_float(w[j] & 0xffff0000u)); } }
      m = mn;
    }
    const float lse = m + logf(z), iz = 1.0f / z;
    const float Mn = fmaxf(M, lse), f = expf(M - Mn), p = expf(lse - Mn);
    W = W * f + p;
#pragma unroll
    for (int d = 0; d < 64; ++d) acc[d] = fmaf(acc[d], f, p * (o[d] * iz));
    M = Mn;
  }
  float ss = 0.f; const float iw = 1.0f / W;
#pragma unroll
  for (int d = 0; d < 64; ++d) { acc[d] *= iw; ss = fmaf(acc[d], acc[d], ss); }
  const float rs = rsqrtf(ss * (1.0f / 64.0f) + EPS);
  us* op = mix + (size_t)tok * DM + 512 + h * 64;
#pragma unroll
  for (int d = 0; d < 64; ++d) op[d] = f2bf(acc[d] * rs * dng[d]);
}

extern "C" void kernel_launch(void* const* d_in, const int* in_sizes, int n_in, void* d_out, int out_size, void* d_ws, size_t ws_size, hipStream_t stream) {
  static int grid = 0;
  if (grid == 0) {
    int dev = 0, cus = 0;
    if (hipGetDevice(&dev) != hipSuccess || hipDeviceGetAttribute(&cus, hipDeviceAttributeMultiprocessorCount, dev) != hipSuccess) { grid = -1; return; }
    if (hipFuncSetAttribute((const void*)mk_fwd, hipFuncAttributeMaxDynamicSharedMemorySize, LDS_BYTES) != hipSuccess) { fprintf(stderr, "hipFuncSetAttribute failed\n"); grid = -1; return; }
    grid = cus;
  }
  if (grid < 0) return;
  char* ws = (char*)d_ws;
  (void)hipMemsetAsync(ws + OFF_CTL, 0, 1 * MiB, stream);
  Args a{};
  for (int i = 0; i < 18; ++i) a.in[i] = (const float*)d_in[i];
  a.out = (float*)d_out; a.ws = (unsigned char*)d_ws;
  us* proj = (us*)(ws + OFF_PROJ); us* mix = (us*)(ws + OFF_A);
  (void)proj; (void)mix;
  a.ph_lo = 0; a.ph_hi = 9; a.li = 0;
  hipLaunchKernelGGL(mk_fwd, dim3(grid), dim3(NWAVES * 64), LDS_BYTES, stream, a);
}
```
